# Optimizing an MI355X kernel written in HIP

```python
import jax, jax.numpy as jnp
from jax import lax
import numpy as np

D_MODEL = 2048
BATCH = 4
SEQ = 8192
DEPTH = 4

HEAD_DIM = 64
D_MIX = D_MODEL
D_ATTN = D_MIX // 2
D_GMLP = D_MIX - D_ATTN
N_Q_HEADS = D_ATTN // HEAD_DIM
N_KV_HEADS = 4
N_GMLP_HEADS = D_GMLP // HEAD_DIM
WINDOW = 128
CHUNK = 128
RMS_EPS = 1e-6
D_KV = N_KV_HEADS * HEAD_DIM
D_IN = D_ATTN + 2 * D_KV + D_ATTN + 3 * D_GMLP

kernel_name = "hybrid_swa_sink_gmlp_parallel_heads"


def _rmsnorm(x, g):
    xf = x.astype(jnp.float32)
    y = xf * lax.rsqrt(jnp.mean(xf * xf, axis=-1, keepdims=True) + RMS_EPS)
    return (y * g.astype(jnp.float32)).astype(x.dtype)


def _alibi_slopes(n):
    return jnp.asarray(2.0 ** (-8.0 * np.arange(1, n + 1) / n), dtype=jnp.float32)


def _band(t, nb):
    B, S, H, D = t.shape
    tb = t.reshape(B, nb, WINDOW, H, D)
    prev = jnp.pad(tb, ((0, 0), (1, 0), (0, 0), (0, 0), (0, 0)))[:, :-1]
    return jnp.concatenate([prev, tb], axis=2)


def _swa_gqa_sinks(q, k, v, sinks, slopes):
    B, S, Hq, Dh = q.shape
    Hkv = k.shape[2]
    G = Hq // Hkv
    nb = S // WINDOW
    qb = q.reshape(B, nb, WINDOW, Hkv, G, Dh)
    kb = _band(k, nb)
    vb = _band(v, nb)
    scores = jnp.einsum('bnqhgd,bnkhd->bnhgqk', qb, kb).astype(jnp.float32) * (Dh ** -0.5)
    qpos = jnp.arange(WINDOW)[:, None] + WINDOW
    kpos = jnp.arange(2 * WINDOW)[None, :]
    dist = qpos - kpos
    in_window = (dist >= 0) & (dist < WINDOW)
    not_pad = (jnp.arange(nb)[:, None] > 0) | (kpos >= WINDOW)
    mask = in_window[None] & not_pad[:, None, :]
    sl = slopes.reshape(Hkv, G)
    alibi = -sl[:, :, None, None] * dist.astype(jnp.float32)[None, None]
    scores = jnp.where(mask[None, :, None, None], scores + alibi[None, None], -jnp.inf)
    sink = sinks.astype(jnp.float32).reshape(Hkv, G)[None, None, :, :, None, None]
    m = jnp.maximum(jnp.max(scores, axis=-1, keepdims=True), sink)
    p = jnp.exp(scores - m)
    p = p / (jnp.sum(p, axis=-1, keepdims=True) + jnp.exp(sink - m))
    out = jnp.einsum('bnhgqk,bnkhd->bnqhgd', p.astype(v.dtype), vb)
    return out.reshape(B, S, Hq * Dh)


def _chunked_sgu(u, v, w_s, b_s):
    B, S, H, C = v.shape
    nc = S // CHUNK
    vc = v.reshape(B, nc, CHUNK, H, C)
    w = jnp.tril(w_s)
    mixed = jnp.einsum('hts,bnshc->bnthc', w, vc) + jnp.transpose(b_s)[None, None, :, :, None]
    return u * mixed.reshape(B, S, H, C)


def setup_inputs(seed: int = 0) -> dict:
    key = jax.random.key(seed)
    ks = jax.random.split(key, 9)
    f32 = jnp.float32
    x = jax.random.normal(ks[0], (BATCH, SEQ, D_MODEL), f32)
    norm_g = 1.0 + 0.02 * jax.random.normal(ks[1], (DEPTH, D_MODEL), f32)
    w_in = jax.random.normal(ks[2], (DEPTH, D_MODEL, D_IN), f32) * (D_MODEL ** -0.5)
    q_norm = 1.0 + 0.02 * jax.random.normal(ks[3], (DEPTH, HEAD_DIM), f32)
    k_norm = 1.0 + 0.02 * jax.random.normal(ks[4], (DEPTH, HEAD_DIM), f32)
    sinks = 0.5 * jax.random.normal(ks[5], (DEPTH, N_Q_HEADS), f32)
    w_s = jax.random.normal(ks[6], (DEPTH, N_GMLP_HEADS, CHUNK, CHUNK), f32) * (0.5 * CHUNK ** -0.5)
    b_s = 1.0 + 0.02 * jax.random.normal(ks[7], (DEPTH, N_GMLP_HEADS, CHUNK), f32)
    w_out = jax.random.normal(ks[8], (DEPTH, D_MIX, D_MODEL), f32) * (0.5 * D_MIX ** -0.5)
    return {"x": x, "norm_g": norm_g, "w_in": w_in, "q_norm": q_norm, "k_norm": k_norm,
            "sinks": sinks, "w_s": w_s, "b_s": b_s, "w_out": w_out}


def reference(x, norm_g, w_in, q_norm, k_norm, sinks, w_s, b_s, w_out):
    B, S, _ = x.shape
    slopes = _alibi_slopes(N_Q_HEADS)
    sizes = [D_ATTN, D_KV, D_KV, D_ATTN, D_GMLP, D_GMLP, D_GMLP]
    cuts = [int(c) for c in np.cumsum(sizes)[:-1]]
    for l in range(DEPTH):
        h = _rmsnorm(x, norm_g[l])
        proj = jnp.einsum('bsd,de->bse', h, w_in[l])
        q, k, v, g_a, z_u, z_v, g_b = jnp.split(proj, cuts, axis=-1)
        q = _rmsnorm(q.reshape(B, S, N_Q_HEADS, HEAD_DIM), q_norm[l])
        k = _rmsnorm(k.reshape(B, S, N_KV_HEADS, HEAD_DIM), k_norm[l])
        v = v.reshape(B, S, N_KV_HEADS, HEAD_DIM)
        attn = _swa_gqa_sinks(q, k, v, sinks[l], slopes) * jax.nn.silu(g_a)
        z_u = jax.nn.gelu(z_u, approximate=False).reshape(B, S, N_GMLP_HEADS, HEAD_DIM)
        z_v = jax.nn.gelu(z_v, approximate=False).reshape(B, S, N_GMLP_HEADS, HEAD_DIM)
        sgu = _chunked_sgu(z_u, z_v, w_s[l], b_s[l]).reshape(B, S, D_GMLP) * jax.nn.silu(g_b)
        mix = jnp.concatenate([attn, sgu], axis=-1)
        x = x + jnp.einsum('bse,ed->bsd', mix, w_out[l])
    return x
```

```cpp
#include <hip/hip_runtime.h>
#include <hip/hip_cooperative_groups.h>
#include <cstdio>
#include <cstdint>
namespace cg = cooperative_groups;

#define LAS __attribute__((address_space(3)))
typedef unsigned short bf16_t;
typedef short bf16x8 __attribute__((ext_vector_type(8)));
typedef float f32x4 __attribute__((ext_vector_type(4)));
typedef float f32x2 __attribute__((ext_vector_type(2)));
typedef unsigned u32x4 __attribute__((ext_vector_type(4)));
typedef unsigned u32x2 __attribute__((ext_vector_type(2)));

constexpr int BATCH = 4, SEQ = 8192, DM = 2048, DEPTH = 4, HD = 64;
constexpr int M = BATCH * SEQ;
constexpr int DIN = 5632;
constexpr int WU = 2560, WVS = 3584, WGB = 4608;
constexpr int DP = 4608;
constexpr int CQ = 0, CK = 1024, CV = 1280, CGA = 1536, CVS = 2560, CUG = 3584;
constexpr float RMS_EPS = 1e-6f;
constexpr float LOG2E = 1.4426950408889634f;
constexpr float QSCALE = 0.125f * LOG2E;

constexpr size_t WIN_L = (size_t)DIN * DM * 2, WOUT_L = (size_t)DM * DM * 2, WSB_L = (size_t)16 * 128 * 128 * 2;
constexpr size_t WS_WIN = 0;
constexpr size_t WS_WOUT = WS_WIN + DEPTH * WIN_L;
constexpr size_t WS_WSB = WS_WOUT + DEPTH * WOUT_L;
constexpr size_t WS_RSS = WS_WSB + DEPTH * WSB_L;
constexpr size_t WS_XB = WS_RSS + (size_t)DEPTH * M * 4;
constexpr size_t WS_PROJ = WS_XB + (size_t)M * DM * 2;
constexpr size_t WS_MIX = WS_PROJ + (size_t)M * DIN * 2;
constexpr size_t WS_BAR = WS_MIX + (size_t)M * DM * 2;
constexpr size_t WS_END = WS_BAR + 16384;

#define REP_MIX 1
#define PREFETCH_KQ 0
#define REP_G1 1
constexpr int NWAVES = 8;
constexpr int MISC_OFF = 147456;
constexpr int LDS_BYTES = 147456 + 256;

namespace pg8 {
constexpr int BM = 256, BK = 64, HALF = 128, HTB = HALF * BK * 2, STAGE_BYTES = 8 * HTB, NXCD = 8, WGM = 8;
__host__ __device__ __forceinline__ int lds_byte(int r, int c) { const int st = (r >> 4) * 2 + (c >> 5), rr = r & 15, cc = c & 31, ob = rr * 64 + cc * 2; return st * 1024 + (ob ^ (((ob >> 9) & 1) << 5)); }
__host__ __device__ __forceinline__ void stage_rc(int b, int& R, int& C) { const int st = b / 1024, sb = b % 1024, swz = sb ^ (((sb >> 9) & 1) << 5); R = (st >> 1) * 16 + swz / 64; C = (st & 1) * 32 + (swz % 64) / 2; }
__host__ __device__ __forceinline__ int perm32(int rho) { const int n = rho >> 4, i = rho & 15; return 8 * (i >> 2) + 4 * n + (i & 3); }

struct Unit { int pm, pn; };
struct Gemm { const bf16_t* A; const bf16_t* Bt; int M, N, K; };

struct StaticOrder {
    int nM, nN, nwg, G, c;
    __host__ __device__ void init(int M_, int N_, int G_, int c_) { nM = M_ / BM; nN = N_ / BM; nwg = nM * nN; G = G_; c = c_; }
    __host__ __device__ bool next(int i, Unit& u) const {
        const long L = (long)i * G + c; if (L >= nwg) return false;
        int wgid = (int)L; { const int q = nwg / NXCD, r = nwg % NXCD, xcd = wgid % NXCD, off = wgid / NXCD; wgid = (xcd < r ? xcd * (q + 1) : r * (q + 1) + (xcd - r) * q) + off; }
        const int nig = WGM * nN, gid = wgid / nig, fm = gid * WGM, gsz = (nM - fm) < WGM ? (nM - fm) : WGM;
        u.pm = fm + ((wgid % nig) % gsz); u.pn = (wgid % nig) / gsz; return true;
    }
};

__device__ __forceinline__ float bf_lo_(unsigned w) { return __uint_as_float(w << 16); }
__device__ __forceinline__ float bf_hi_(unsigned w) { return __uint_as_float(w & 0xffff0000u); }
typedef __bf16 bf16x2_t __attribute__((ext_vector_type(2)));
__device__ __forceinline__ unsigned cvt_pk_bf16(float lo, float hi) { const f32x2 v = {lo, hi}; const bf16x2_t b = __builtin_convertvector(v, bf16x2_t); return __builtin_bit_cast(unsigned, b); }
__device__ __forceinline__ f32x2 gelu_pk(f32x2 v) {
    f32x2 z = v * 0.70710678118f; z.x = __builtin_amdgcn_fmed3f(z.x, -3.0f, 3.0f); z.y = __builtin_amdgcn_fmed3f(z.y, -3.0f, 3.0f);
    const f32x2 t = (z * z) * 0.22222222222f + (-1.0f);
    f32x2 p = t * 1.277356223e-03f + (-3.382316293e-03f);
    p = p * t + 5.076752329e-03f; p = p * t + (-1.096681142e-02f); p = p * t + 2.438735024e-02f; p = p * t + (-4.437217044e-02f); p = p * t + 7.247759867e-02f;
    p = p * t + (-1.100018504e-01f); p = p * t + 1.575016831e-01f; p = p * t + (-2.288030019e-01f); p = p * t + 4.701317549e-01f;
    const f32x2 phi = (z * p) * 0.5f + 0.5f;
    return v * phi;
}
__device__ __forceinline__ float silu_f(float v) { return v * __builtin_amdgcn_rcpf(1.0f + __builtin_amdgcn_exp2f(-LOG2E * v)); }
__device__ __forceinline__ f32x4 gelu4(f32x4 v) { const f32x2 a = gelu_pk((f32x2){v[0], v[1]}), b = gelu_pk((f32x2){v[2], v[3]}); return (f32x4){a.x, a.y, b.x, b.y}; }
__device__ __forceinline__ f32x4 silu4(f32x4 v) { return (f32x4){silu_f(v[0]), silu_f(v[1]), silu_f(v[2]), silu_f(v[3])}; }
__device__ __forceinline__ u32x4 pack8(f32x4 v0, f32x4 v1) { u32x4 w; w.x = cvt_pk_bf16(v0[0], v0[1]); w.y = cvt_pk_bf16(v0[2], v0[3]); w.z = cvt_pk_bf16(v1[0], v1[1]); w.w = cvt_pk_bf16(v1[2], v1[3]); return w; }

struct EpiProj {
    static constexpr bool MIXED = true;
    bf16_t* O; const float* rss; const float* qn; const float* kn;
    template <int MODE> __device__ __forceinline__ void plain(const f32x4 (&acc)[2][2][4][2], const float (&rs)[2][4], bf16_t* base, int row0) const {
#pragma unroll
        for (int ai = 0; ai < 2; ++ai)
#pragma unroll
            for (int m = 0; m < 4; ++m) {
                bf16_t* rowp = base + (size_t)(row0 + ai * HALF + m * 16) * DP;
#pragma unroll
                for (int bj = 0; bj < 2; ++bj) { f32x4 v0 = acc[ai][bj][m][0] * rs[ai][m], v1 = acc[ai][bj][m][1] * rs[ai][m];
                    if (MODE == 2) { v0 = gelu4(v0); v1 = gelu4(v1); } else if (MODE == 1) { v0 = silu4(v0); v1 = silu4(v1); }
                    *(u32x4*)(rowp + bj * 32) = pack8(v0, v1); }
            }
    }
    __device__ __forceinline__ void operator()(const f32x4 (&acc)[2][2][4][2], const Unit& u, int wr, int wc, int fr, int fq) const {
        const int row0 = u.pm * BM + wr * 64 + fr, pn = u.pn;
        float rs[2][4];
#pragma unroll
        for (int ai = 0; ai < 2; ++ai)
#pragma unroll
            for (int m = 0; m < 4; ++m) rs[ai][m] = rss[row0 + ai * HALF + m * 16];
        f32x4 gv[2][2];
        if (pn < 5) { const float* gsrc = (pn < 4) ? qn : kn; const float sc = (pn < 4) ? QSCALE : 1.0f;
#pragma unroll
            for (int bj = 0; bj < 2; ++bj)
#pragma unroll
                for (int n = 0; n < 2; ++n) gv[bj][n] = *(const f32x4*)(gsrc + 32 * bj + 8 * fq + 4 * n) * sc; }
#pragma unroll
        for (int ai = 0; ai < 2; ++ai)
#pragma unroll
            for (int m = 0; m < 4; ++m) rs[ai][m] = rsqrtf(rs[ai][m] * (1.0f / DM) + RMS_EPS);
        if (pn >= 14) {
            bf16_t* base = O + CUG + (pn - 14) * 128 + wc * 32 + 8 * fq;
#pragma unroll
            for (int ai = 0; ai < 2; ++ai)
#pragma unroll
                for (int m = 0; m < 4; ++m) {
                    const f32x4 u0 = gelu4(acc[ai][0][m][0] * rs[ai][m]), u1 = gelu4(acc[ai][0][m][1] * rs[ai][m]);
                    const f32x4 g0 = silu4(acc[ai][1][m][0] * rs[ai][m]), g1 = silu4(acc[ai][1][m][1] * rs[ai][m]);
                    *(u32x4*)(base + (size_t)(row0 + ai * HALF + m * 16) * DP) = pack8(u0 * g0, u1 * g1);
                }
            return;
        }
        bf16_t* base = O + (pn < 10 ? pn * BM : CVS + (pn - 10) * BM) + wc * 64 + 8 * fq;
        if (pn < 5) {
#pragma unroll
            for (int ai = 0; ai < 2; ++ai)
#pragma unroll
                for (int m = 0; m < 4; ++m) {
                    f32x4 v[2][2]; float ss = 0.f;
#pragma unroll
                    for (int bj = 0; bj < 2; ++bj)
#pragma unroll
                        for (int n = 0; n < 2; ++n) { v[bj][n] = acc[ai][bj][m][n] * rs[ai][m]; const f32x4 x = v[bj][n]; ss += (x[0] * x[0] + x[1] * x[1]) + (x[2] * x[2] + x[3] * x[3]); }
                    ss += __shfl_xor(ss, 16); ss += __shfl_xor(ss, 32);
                    const float r = rsqrtf(ss * (1.0f / HD) + RMS_EPS);
                    bf16_t* rowp = base + (size_t)(row0 + ai * HALF + m * 16) * DP;
#pragma unroll
                    for (int bj = 0; bj < 2; ++bj) *(u32x4*)(rowp + bj * 32) = pack8(v[bj][0] * r * gv[bj][0], v[bj][1] * r * gv[bj][1]);
                }
        } else if (pn == 5) plain<0>(acc, rs, base, row0);
        else if (pn >= 10) plain<2>(acc, rs, base, row0);
        else plain<1>(acc, rs, base, row0);
    }
};
template <bool IN_F32, bool OUT_F32> struct EpiRes {
    static constexpr bool MIXED = false;
    const float* xin; float* xout; bf16_t* xb; float* rss_next;
    __device__ __forceinline__ void operator()(const f32x4 (&acc)[2][2][4][2], const Unit& u, int wr, int wc, int fr, int fq) const {
        const int row0 = u.pm * BM + wr * 64 + fr; const int col0 = u.pn * BM + wc * 64 + 8 * fq;
        u32x4 xw[2][4][2];
        if (!IN_F32) {
#pragma unroll
            for (int ai = 0; ai < 2; ++ai)
#pragma unroll
                for (int m = 0; m < 4; ++m)
#pragma unroll
                    for (int bj = 0; bj < 2; ++bj) xw[ai][m][bj] = *(const u32x4*)(xb + (size_t)(row0 + ai * HALF + m * 16) * DM + col0 + bj * 32);
            __builtin_amdgcn_sched_barrier(0);
        }
#pragma unroll
        for (int ai = 0; ai < 2; ++ai) {
            f32x4 xv[4][2][2];
            if (IN_F32) {
#pragma unroll
                for (int m = 0; m < 4; ++m)
#pragma unroll
                    for (int bj = 0; bj < 2; ++bj) { const size_t off = (size_t)(row0 + ai * HALF + m * 16) * DM + col0 + bj * 32; xv[m][bj][0] = *(const f32x4*)(xin + off); xv[m][bj][1] = *(const f32x4*)(xin + off + 4); }
                __builtin_amdgcn_sched_barrier(0);
            }
#pragma unroll
            for (int m = 0; m < 4; ++m) {
                const int row = row0 + ai * HALF + m * 16; const size_t off = (size_t)row * DM + col0; float ss = 0.f;
#pragma unroll
                for (int bj = 0; bj < 2; ++bj) {
                    f32x4 b0, b1;
                    if (IN_F32) { b0 = xv[m][bj][0]; b1 = xv[m][bj][1]; }
                    else { const u32x4 w = xw[ai][m][bj]; b0 = (f32x4){bf_lo_(w.x), bf_hi_(w.x), bf_lo_(w.y), bf_hi_(w.y)}; b1 = (f32x4){bf_lo_(w.z), bf_hi_(w.z), bf_lo_(w.w), bf_hi_(w.w)}; }
                    const f32x4 v0 = acc[ai][bj][m][0] + b0, v1 = acc[ai][bj][m][1] + b1;
                    if (OUT_F32) { *(f32x4*)(xout + off + bj * 32) = v0; *(f32x4*)(xout + off + bj * 32 + 4) = v1; }
                    else {
                        ss += (v0[0] * v0[0] + v0[1] * v0[1]) + (v0[2] * v0[2] + v0[3] * v0[3]) + (v1[0] * v1[0] + v1[1] * v1[1]) + (v1[2] * v1[2] + v1[3] * v1[3]);
                        *(u32x4*)(xb + off + bj * 32) = pack8(v0, v1); }
                }
                if (!OUT_F32) { ss += __shfl_xor(ss, 16); ss += __shfl_xor(ss, 32); if (fq == 0) atomicAdd(rss_next + row, ss); }
            }
            __builtin_amdgcn_sched_barrier(0);
        }
    }
};

template <class Epi, class Sched>
__device__ __forceinline__ void gemm_phase(LAS unsigned char* lds, const Gemm g, const Sched& S, const Epi& E, int tid_in) {
    int tid_ = tid_in; asm volatile("" : "+v"(tid_));
    const int tid = tid_, wid = __builtin_amdgcn_readfirstlane(tid >> 6), lane = tid & 63, wr = wid >> 2, wc = wid & 3, fr = lane & 15, fq = lane >> 4;
    const int K = g.K, nt = K / BK;
    unsigned voffA[2], voffB[2];
#pragma unroll
    for (int i = 0; i < 2; ++i) { int R, C; stage_rc(tid * 16 + i * 8192, R, C); const int Rb = 64 * (R >> 5) + perm32(R & 31);
        voffA[i] = (unsigned)(R * K + C) * 2u; voffB[i] = (unsigned)(Rb * K + C) * 2u; }
    const size_t kstep = (size_t)(BK * 2);
    const size_t hstep = (size_t)HALF * K * 2;
    const size_t hstepB = (size_t)32 * K * 2;
    const size_t tstep = 2 * hstep;
    const size_t adjB0 = (size_t)(0 + (wid >> 2)) * 32 * K * 2, adjB1 = (size_t)(2 + (wid >> 2)) * 32 * K * 2;
#define PG8_BROW(pn) (Epi::MIXED ? ((pn) < 10 ? (pn) * BM : ((pn) < 14 ? WVS + ((pn) - 10) * BM : WU + ((pn) - 14) * 128)) : (pn) * BM)
#define PG8_ISMIX(pn) (Epi::MIXED && (pn) >= 14)
    const unsigned ldsw = (unsigned)wid * 1024u;
    const int aoff = lds_byte(wr * 64 + fr, fq * 8), boff = lds_byte(wc * 32 + fr, fq * 8);
#define PG8_SA(b, h) (((b) * 2 + (h)) * HTB)
#define PG8_SB(b, h) ((4 + (b) * 2 + (h)) * HTB)
#define PG8_STAGE(bufoff, gbase, voff) do { _Pragma("unroll") for (int _i = 0; _i < 2; ++_i) \
        __builtin_amdgcn_global_load_lds((const unsigned*)((const char*)(gbase) + (voff)[_i]), (LAS unsigned*)(lds + (bufoff) + ldsw + _i * 8192), 16, 0, 0); } while (0)
#define PG8_STAGEB(bufoff, gbase, mx) do { \
        __builtin_amdgcn_global_load_lds((const unsigned*)((const char*)(gbase) - ((mx) ? adjB0 : 0) + voffB[0]), (LAS unsigned*)(lds + (bufoff) + ldsw), 16, 0, 0); \
        __builtin_amdgcn_global_load_lds((const unsigned*)((const char*)(gbase) - ((mx) ? adjB1 : 0) + voffB[1]), (LAS unsigned*)(lds + (bufoff) + ldsw + 8192), 16, 0, 0); } while (0)
#define PG8_LDA(dst, b, h) do { _Pragma("unroll") for (int m = 0; m < 4; ++m) _Pragma("unroll") for (int k = 0; k < 2; ++k) dst[m][k] = *(const LAS bf16x8*)(lds + PG8_SA(b, h) + aoff + m * 2048 + k * 1024); } while (0)
#define PG8_LDB(dst, b, h) do { _Pragma("unroll") for (int n = 0; n < 2; ++n) _Pragma("unroll") for (int k = 0; k < 2; ++k) dst[n][k] = *(const LAS bf16x8*)(lds + PG8_SB(b, h) + boff + n * 2048 + k * 1024); } while (0)
#define PG8_MMA(ai, bj, At, Bt) do { __builtin_amdgcn_s_setprio(1); _Pragma("unroll") for (int m = 0; m < 4; ++m) _Pragma("unroll") for (int n = 0; n < 2; ++n) _Pragma("unroll") for (int k = 0; k < 2; ++k) \
        acc[ai][bj][m][n] = __builtin_amdgcn_mfma_f32_16x16x32_bf16(Bt[n][k], At[m][k], acc[ai][bj][m][n], 0, 0, 0); __builtin_amdgcn_s_setprio(0); } while (0)
#define PG8_WAIT_V(n) asm volatile("s_waitcnt vmcnt(" #n ")" ::: "memory")
#define PG8_WAIT_L(n) asm volatile("s_waitcnt lgkmcnt(" #n ")" ::: "memory")
#define PG8_BAR __builtin_amdgcn_s_barrier()
#define PG8_SCHED __builtin_amdgcn_sched_barrier(0)
    Unit cur, nxt; int ui = 0;
    if (!S.next(0, cur)) return;
    const char* cA = (const char*)g.A + (size_t)cur.pm * tstep; const char* cB = (const char*)g.Bt + (size_t)PG8_BROW(cur.pn) * K * 2;
    bool mc = PG8_ISMIX(cur.pn); size_t hbc = mc ? (size_t)(WGB - WU) * K * 2 : hstepB;
    PG8_STAGEB(PG8_SB(0, 0), cB, mc); PG8_STAGEB(PG8_SB(0, 1), cB + hbc, mc); PG8_STAGE(PG8_SA(0, 0), cA, voffA); PG8_STAGE(PG8_SA(0, 1), cA + hstep, voffA);
    if (wr == 1) PG8_BAR;
    PG8_WAIT_V(2); PG8_BAR;
    PG8_STAGEB(PG8_SB(1, 0), cB + kstep, mc); PG8_STAGE(PG8_SA(1, 0), cA + kstep, voffA); PG8_STAGEB(PG8_SB(1, 1), cB + hbc + kstep, mc);
    PG8_WAIT_V(6); PG8_BAR; PG8_SCHED;
    f32x4 acc[2][2][4][2];
#pragma unroll
    for (int a = 0; a < 2; ++a)
#pragma unroll
        for (int b = 0; b < 2; ++b)
#pragma unroll
            for (int m = 0; m < 4; ++m)
#pragma unroll
                for (int n = 0; n < 2; ++n) acc[a][b][m][n] = (f32x4){0.f, 0.f, 0.f, 0.f};
    bf16x8 At[4][2], B0[2][2], B1[2][2];
    for (;;) {
        const bool has_next = S.next(ui + 1, nxt);
        const char* nA = has_next ? (const char*)g.A + (size_t)nxt.pm * tstep : cA; const char* nB = has_next ? (const char*)g.Bt + (size_t)PG8_BROW(nxt.pn) * K * 2 : cB;
        const bool mn = has_next ? PG8_ISMIX(nxt.pn) : mc; const size_t hbn = mn ? (size_t)(WGB - WU) * K * 2 : hstepB;
        for (int t = 0; t < nt; t += 2) {
            const bool last = (t == nt - 2);
            const char* a1 = cA + (size_t)(t + 1) * kstep;
            const char* a2 = last ? nA : cA + (size_t)(t + 2) * kstep; const char* b2 = last ? nB : cB + (size_t)(t + 2) * kstep;
            const char* a3 = a2 + kstep; const char* b3 = b2 + kstep;
            const bool m2 = last ? mn : mc; const size_t hb2 = last ? hbn : hbc;
            PG8_LDB(B0, 0, 0); PG8_LDB(B1, 0, 1); PG8_SCHED; PG8_LDA(At, 0, 0); PG8_STAGE(PG8_SA(1, 1), a1 + hstep, voffA);
            PG8_WAIT_V(8); PG8_WAIT_L(0); PG8_BAR; PG8_MMA(0, 0, At, B0); PG8_MMA(0, 1, At, B1); PG8_BAR; PG8_SCHED;
            PG8_LDA(At, 0, 1); PG8_STAGEB(PG8_SB(0, 0), b2, m2); PG8_STAGEB(PG8_SB(0, 1), b2 + hb2, m2); PG8_STAGE(PG8_SA(0, 0), a2, voffA);
            PG8_WAIT_V(8); PG8_WAIT_L(0); PG8_BAR; PG8_MMA(1, 0, At, B0); PG8_MMA(1, 1, At, B1); PG8_BAR; PG8_SCHED;
            PG8_LDB(B0, 1, 0); PG8_LDB(B1, 1, 1); PG8_SCHED; PG8_LDA(At, 1, 0); PG8_STAGE(PG8_SA(0, 1), a2 + hstep, voffA);
            PG8_WAIT_V(8); PG8_WAIT_L(0); PG8_BAR; PG8_MMA(0, 0, At, B0); PG8_MMA(0, 1, At, B1); PG8_BAR; PG8_SCHED;
            PG8_LDA(At, 1, 1); PG8_STAGEB(PG8_SB(1, 0), b3, m2); PG8_STAGEB(PG8_SB(1, 1), b3 + hb2, m2); PG8_STAGE(PG8_SA(1, 0), a3, voffA);
            PG8_WAIT_V(8); PG8_WAIT_L(0); PG8_BAR; PG8_MMA(1, 0, At, B0); PG8_MMA(1, 1, At, B1); PG8_BAR; PG8_SCHED;
        }
        if (wr == 0) PG8_BAR;
        E(acc, cur, wr, wc, fr, fq);
        if (!has_next) break;
#pragma unroll
        for (int a = 0; a < 2; ++a)
#pragma unroll
            for (int b = 0; b < 2; ++b)
#pragma unroll
                for (int m = 0; m < 4; ++m)
#pragma unroll
                    for (int n = 0; n < 2; ++n) acc[a][b][m][n] = (f32x4){0.f, 0.f, 0.f, 0.f};
        cur = nxt; cA = nA; cB = nB; mc = mn; hbc = hbn; ++ui;
        if (wr == 1) PG8_BAR;
    }
    PG8_WAIT_V(0);
    PG8_BAR;
#undef PG8_SA
#undef PG8_SB
#undef PG8_STAGE
#undef PG8_LDA
#undef PG8_STAGEB
#undef PG8_BROW
#undef PG8_ISMIX
#undef PG8_LDB
#undef PG8_MMA
#undef PG8_WAIT_V
#undef PG8_WAIT_L
#undef PG8_BAR
#undef PG8_SCHED
}
}

__device__ __forceinline__ unsigned f2bf(float f) { unsigned u = __builtin_bit_cast(unsigned, f); return (u + 0x7fffu + ((u >> 16) & 1u)) >> 16; }
__device__ __forceinline__ unsigned pk2(float lo, float hi) { return f2bf(lo) | (f2bf(hi) << 16); }
__device__ __forceinline__ float bf_lo(unsigned w) { return __uint_as_float(w << 16); }
__device__ __forceinline__ float bf_hi(unsigned w) { return __uint_as_float(w & 0xffff0000u); }
__device__ __forceinline__ float bf2f(bf16_t b) { return __uint_as_float((unsigned)b << 16); }
__device__ __forceinline__ float wave_sum(float v) {
#pragma unroll
    for (int o = 1; o < 64; o <<= 1) v += __shfl_xor(v, o);
    return v;
}

__device__ __forceinline__ int lane_id() { int r; asm volatile("v_mbcnt_lo_u32_b32 %0, -1, 0\n\tv_mbcnt_hi_u32_b32 %0, -1, %0" : "=v"(r)); return r; }

struct Args {
    const float* x; const float* norm_g; const float* w_in; const float* q_norm; const float* k_norm; const float* sinks; const float* w_s; const float* b_s; const float* w_out;
    float* out; unsigned char* ws;
};

__device__ __forceinline__ void p0_transpose_item(const float* W, int K, int N, bf16_t* WT, const float* gk, LAS float* scr, int item, int lane) {
    const int nblk = N / 64, kb = item / nblk, nb = item % nblk, k0 = 64 * kb, n0 = 64 * nb;
    const int r4 = lane >> 4, c4 = lane & 15;
    f32x4 v[16];
#pragma unroll
    for (int i = 0; i < 16; ++i) v[i] = __builtin_nontemporal_load((const f32x4*)(W + (size_t)(k0 + 4 * i + r4) * N + n0 + 4 * c4));
#pragma unroll
    for (int i = 0; i < 16; ++i) { LAS float* d = scr + (4 * i + r4) * 65 + 4 * c4; d[0] = v[i][0]; d[1] = v[i][1]; d[2] = v[i][2]; d[3] = v[i][3]; }
    asm volatile("s_waitcnt lgkmcnt(0)" ::: "memory");
    const int c = lane & 7, ns = lane >> 3;
    float gsc[8];
#pragma unroll
    for (int e = 0; e < 8; ++e) gsc[e] = gk ? gk[k0 + 8 * c + e] : 1.0f;
#pragma unroll
    for (int j = 0; j < 8; ++j) { const int n = 8 * j + ns; const LAS float* sp = scr + (8 * c) * 65 + n;
        u32x4 o; o.x = pk2(sp[0 * 65] * gsc[0], sp[1 * 65] * gsc[1]); o.y = pk2(sp[2 * 65] * gsc[2], sp[3 * 65] * gsc[3]); o.z = pk2(sp[4 * 65] * gsc[4], sp[5 * 65] * gsc[5]); o.w = pk2(sp[6 * 65] * gsc[6], sp[7 * 65] * gsc[7]);
        *(u32x4*)(WT + (size_t)(n0 + n) * K + k0 + 8 * c) = o; }
    asm volatile("s_waitcnt lgkmcnt(0)" ::: "memory");
}
__device__ __forceinline__ void p0_prologue(const Args& a, LAS unsigned char* lds, int wave, int lane) {
    LAS float* scr = (LAS float*)(lds + wave * 18432);
    const int gw = blockIdx.x * NWAVES + wave, NGW = gridDim.x * NWAVES;
    constexpr int I_IN = (DM / 64) * (DIN / 64), I_OUT = (DM / 64) * (DM / 64), I_L = I_IN + I_OUT;
    for (int it = gw; it < DEPTH * I_L; it += NGW) {
        const int l = it / I_L; int r = it % I_L;
        if (r < I_IN) p0_transpose_item(a.w_in + (size_t)l * DM * DIN, DM, DIN, (bf16_t*)(a.ws + WS_WIN + l * WIN_L), a.norm_g + l * DM, scr, r, lane);
        else p0_transpose_item(a.w_out + (size_t)l * DM * DM, DM, DM, (bf16_t*)(a.ws + WS_WOUT + l * WOUT_L), nullptr, scr, r - I_IN, lane);
    }
    { const int gt = blockIdx.x * (NWAVES * 64) + threadIdx.x, NT = gridDim.x * NWAVES * 64; bf16_t* wsb = (bf16_t*)(a.ws + WS_WSB);
      for (int i = gt; i < DEPTH * 16 * 128 * 128; i += NT) { const int s = i & 127, t = (i >> 7) & 127; wsb[i] = (s <= t) ? (bf16_t)f2bf(a.w_s[i]) : (bf16_t)0; }
      float* rss = (float*)(a.ws + WS_RSS);
      for (int i = gt; i < (DEPTH - 1) * M; i += NT) rss[M + i] = 0.f; }
    { float* rss = (float*)(a.ws + WS_RSS); bf16_t* xb = (bf16_t*)(a.ws + WS_XB);
      for (int m = gw; m < M; m += NGW) {
          const f32x4* xr = (const f32x4*)(a.x + (size_t)m * DM) + lane; u32x2* o = (u32x2*)(xb + (size_t)m * DM) + lane; float s = 0.f;
#pragma unroll
          for (int j = 0; j < 8; ++j) { const f32x4 v = __builtin_nontemporal_load(xr + 64 * j); s += (v[0] * v[0] + v[1] * v[1]) + (v[2] * v[2] + v[3] * v[3]); u32x2 w; w.x = pk2(v[0], v[1]); w.y = pk2(v[2], v[3]); o[64 * j] = w; }
          s = wave_sum(s); if (lane == 0) rss[m] = s; } }
}

typedef short v4i16_t __attribute__((ext_vector_type(4)));
__device__ __forceinline__ bf16x8 tr_frag(LAS unsigned char* pa, LAS unsigned char* pb) {
    const v4i16_t lo = __builtin_amdgcn_ds_read_tr16_b64_v4i16((LAS v4i16_t*)pa), hi = __builtin_amdgcn_ds_read_tr16_b64_v4i16((LAS v4i16_t*)pb);
    return __builtin_shufflevector(lo, hi, 0, 1, 2, 3, 4, 5, 6, 7);
}
__device__ __forceinline__ int vimg_off(int row, int c8) { return row * 128 + ((((c8 >> 1) ^ (((row >> 1) & 3) << 1))) << 4) + ((c8 & 1) << 3); }
#define MFMA16(x, y, c) __builtin_amdgcn_mfma_f32_16x16x32_bf16((x), (y), (c), 0, 0, 0)

#define SBAR0() __builtin_amdgcn_sched_barrier(0)
__device__ __forceinline__ void glds16(const void* gsrc, unsigned lds_dst) { unsigned keep;
    asm volatile("s_mov_b32 %0, m0\n\ts_mov_b32 m0, %2\n\ts_nop 0\n\tglobal_load_lds_dwordx4 %1, off\n\ts_mov_b32 m0, %0" : "=&s"(keep) : "v"(gsrc), "s"(lds_dst) : "memory"); }
__device__ __forceinline__ void attn_mfma(const bf16_t* proj, bf16_t* mix, const float* sinks, LAS unsigned char* lds, int wave, int lane_) {
    int lane = lane_; asm volatile("" : "+v"(lane));
    const int fr = lane & 15, fq = lane >> 4, q4 = (lane & 15) >> 2, p4 = lane & 3;
    for (int blk = blockIdx.x; blk < M / 128; blk += gridDim.x) {
        const int t0 = blk * 128; const bool first = (blk & (SEQ / 128 - 1)) == 0;
        const int tq = t0 + 16 * wave + fr;
        const bf16_t* qrow = proj + (size_t)tq * DP;
        const float sinkv = sinks[lane & 15] * LOG2E;
        const unsigned lds0 = (unsigned)(uintptr_t)lds;
#define DMA_KV(HK, BUF) do { _Pragma("unroll") for (int i4 = 0; i4 < 4; ++i4) { const int ii = 4 * wave + i4, rr = 8 * ii + (lane >> 3), k = (lane & 7) ^ (((rr >> 1) & 3) << 1); \
            int tok = t0 - 128 + rr; if (first && tok < t0) tok = t0; const bf16_t* src = proj + (size_t)tok * DP + 64 * (HK) + 8 * k; \
            glds16(src + CK, (unsigned)__builtin_amdgcn_readfirstlane((int)(lds0 + (BUF) * 65536 + ii * 1024))); \
            glds16(src + CV, (unsigned)__builtin_amdgcn_readfirstlane((int)(lds0 + (BUF) * 65536 + 32768 + ii * 1024))); } } while (0)
#define LOADQ(DST, HQ0) do { _Pragma("unroll") for (int g2 = 0; g2 < 2; ++g2) _Pragma("unroll") for (int s = 0; s < 2; ++s) DST[g2][s] = *(const bf16x8*)(qrow + CQ + 64 * ((HQ0) + g2) + 32 * s + 8 * fq); } while (0)
        asm volatile("s_waitcnt lgkmcnt(0)\n\ts_barrier" ::: "memory");
        DMA_KV(0, 0);
        bf16x8 qn[2][2];
        LOADQ(qn, 0);
        const int kro = 16 * wave + fr;
        const int kof0 = vimg_off(kro, 2 * fq), kof1 = vimg_off(kro, 2 * (4 + fq));
#pragma unroll 1
        for (int hk = 0; hk < 4; ++hk) {
            asm volatile("s_waitcnt vmcnt(0) lgkmcnt(0)\n\ts_barrier" ::: "memory");
            LAS unsigned char* kb = lds + (hk & 1) * 65536; LAS unsigned char* vb = kb + 32768;
#pragma unroll
            for (int gp = 0; gp < 2; ++gp) {
                const int hq0 = 4 * hk + 2 * gp;
                bf16x8 qf[2][2];
#pragma unroll
                for (int g2 = 0; g2 < 2; ++g2)
#pragma unroll
                    for (int s = 0; s < 2; ++s) qf[g2][s] = qn[g2][s];
                if (hq0 + 2 < 16) LOADQ(qn, hq0 + 2);
                u32x4 gav[2][2];
#pragma unroll
                for (int g2 = 0; g2 < 2; ++g2)
#pragma unroll
                    for (int a2 = 0; a2 < 2; ++a2) gav[g2][a2] = *(const u32x4*)(qrow + CGA + 64 * (hq0 + g2) + 32 * a2 + 8 * fq);
                float sref[2], sterm[2]; f32x4 cb[2]; float stp[2];
#pragma unroll
                for (int g2 = 0; g2 < 2; ++g2) {
                    const int hq = hq0 + g2; const float slope2 = exp2f(-0.5f * (float)(hq + 1)) * LOG2E, sink2 = __uint_as_float(__builtin_amdgcn_readlane(__float_as_uint(sinkv), hq));
                    sref[g2] = fminf(fmaxf(sink2, -60.f), 60.f); sterm[g2] = __builtin_amdgcn_exp2f(sink2 - sref[g2]); stp[g2] = slope2 * 16.0f;
                    const float b0 = slope2 * (float)(4 * fq - 128 - fr) - sref[g2];
                    cb[g2] = (f32x4){b0, b0 + slope2, b0 + 2.0f * slope2, b0 + 3.0f * slope2};
                }
                f32x4 S[2][9];
#pragma unroll
                for (int j = 0; j < 9; ++j) {
                    const bf16x8 k0 = *(const LAS bf16x8*)(kb + kof0 + j * 2048), k1 = *(const LAS bf16x8*)(kb + kof1 + j * 2048);
#pragma unroll
                    for (int g2 = 0; g2 < 2; ++g2) {
                        f32x4 c = cb[g2] + stp[g2] * (float)j;
                        if (j == 0) {
#pragma unroll
                            for (int i = 0; i < 4; ++i) c[i] = (4 * fq + i > fr) ? c[i] : -INFINITY; }
                        if (j == 8) {
#pragma unroll
                            for (int i = 0; i < 4; ++i) c[i] = (4 * fq + i <= fr) ? c[i] : -INFINITY; }
                        if (first && j < 8 - wave) c = (f32x4){-INFINITY, -INFINITY, -INFINITY, -INFINITY};
                        S[g2][j] = MFMA16(k0, qf[g2][0], c); S[g2][j] = MFMA16(k1, qf[g2][1], S[g2][j]); }
                }
                SBAR0();
                if (gp == 0 && hk < 3) { if (hk & 1) DMA_KV(hk + 1, 0); else DMA_KV(hk + 1, 1); }
                SBAR0();
                bf16x8 pf[2][5]; float il[2];
                const bf16x8 ones = {0x3F80, 0x3F80, 0x3F80, 0x3F80, 0x3F80, 0x3F80, 0x3F80, 0x3F80};
#pragma unroll
                for (int g2 = 0; g2 < 2; ++g2) {
                    f32x4 L = (f32x4){0.f, 0.f, 0.f, 0.f};
#pragma unroll
                    for (int c = 0; c < 5; ++c) { u32x4 w;
                        w.x = pg8::cvt_pk_bf16(__builtin_amdgcn_exp2f(S[g2][2 * c][0]), __builtin_amdgcn_exp2f(S[g2][2 * c][1])); w.y = pg8::cvt_pk_bf16(__builtin_amdgcn_exp2f(S[g2][2 * c][2]), __builtin_amdgcn_exp2f(S[g2][2 * c][3]));
                        if (c < 4) { w.z = pg8::cvt_pk_bf16(__builtin_amdgcn_exp2f(S[g2][2 * c + 1][0]), __builtin_amdgcn_exp2f(S[g2][2 * c + 1][1])); w.w = pg8::cvt_pk_bf16(__builtin_amdgcn_exp2f(S[g2][2 * c + 1][2]), __builtin_amdgcn_exp2f(S[g2][2 * c + 1][3])); } else { w.z = 0u; w.w = 0u; }
                        pf[g2][c] = __builtin_bit_cast(bf16x8, w);
                        L = MFMA16(ones, pf[g2][c], L); }
                    il[g2] = __builtin_amdgcn_rcpf(L[0] + sterm[g2]);
                }
                SBAR0();
                f32x4 O[2][4];
#pragma unroll
                for (int g2 = 0; g2 < 2; ++g2)
#pragma unroll
                    for (int dt = 0; dt < 4; ++dt) O[g2][dt] = (f32x4){0.f, 0.f, 0.f, 0.f};
#pragma unroll
                for (int c = 0; c < 5; ++c) {
                    bf16x8 vf[4];
#pragma unroll
                    for (int dt = 0; dt < 4; ++dt) { const int ra = 16 * wave + 32 * c + 4 * fq + q4, rb = (c < 4) ? ra + 16 : ra, c8 = 8 * (dt >> 1) + 2 * p4 + (dt & 1);
                        vf[dt] = tr_frag(vb + vimg_off(ra, c8), vb + vimg_off(rb, c8)); }
#pragma unroll
                    for (int dt = 0; dt < 4; ++dt)
#pragma unroll
                        for (int g2 = 0; g2 < 2; ++g2) O[g2][dt] = MFMA16(vf[dt], pf[g2][c], O[g2][dt]);
                }
#pragma unroll
                for (int g2 = 0; g2 < 2; ++g2)
#pragma unroll
                    for (int a2 = 0; a2 < 2; ++a2) {
                        const int col = 64 * (hq0 + g2) + 32 * a2 + 8 * fq; const u32x4 ga = gav[g2][a2];
                        const f32x4 o0 = O[g2][2 * a2] * il[g2], o1 = O[g2][2 * a2 + 1] * il[g2];
                        u32x4 r; r.x = pg8::cvt_pk_bf16(o0[0] * bf_lo(ga.x), o0[1] * bf_hi(ga.x)); r.y = pg8::cvt_pk_bf16(o0[2] * bf_lo(ga.y), o0[3] * bf_hi(ga.y));
                        r.z = pg8::cvt_pk_bf16(o1[0] * bf_lo(ga.z), o1[1] * bf_hi(ga.z)); r.w = pg8::cvt_pk_bf16(o1[2] * bf_lo(ga.w), o1[3] * bf_hi(ga.w));
                        *(u32x4*)(mix + (size_t)tq * DM + col) = r;
                    }
            }
        }
        asm volatile("s_waitcnt lgkmcnt(0)\n\ts_barrier" ::: "memory");
#undef DMA_KV
#undef LOADQ
    }
}
__device__ __forceinline__ void sgu_mfma(const bf16_t* proj, bf16_t* mix, const bf16_t* wsb, const float* bs, LAS unsigned char* vl, int wave, int lane_) {
    int lane = lane_; asm volatile("" : "+v"(lane));
    const int fr = lane & 15, fq = lane >> 4, q4 = (lane & 15) >> 2, p4 = lane & 3;
    for (int blk = blockIdx.x; blk < M / 128; blk += gridDim.x) {
        const int t0 = blk * 128;
#pragma unroll 1
        for (int hh = 0; hh < 2; ++hh) {
            const int h = wave + 8 * hh;
            asm volatile("s_waitcnt lgkmcnt(0)" ::: "memory");
#pragma unroll
            for (int ii = 0; ii < 16; ++ii) {
                const int rr = 8 * ii + (lane >> 3), k = (lane & 7) ^ (((rr >> 1) & 3) << 1);
                __builtin_amdgcn_global_load_lds((const unsigned*)(proj + (size_t)(t0 + rr) * DP + CVS + 64 * h + 8 * k), (LAS unsigned*)(vl + ii * 1024), 16, 0, 0);
            }
            bf16x8 wf[2][2][4]; float bias[2][2];
#define LOADG(BUF, G) do { _Pragma("unroll") for (int ti = 0; ti < 2; ++ti) { const int t = 16 * (2 * (G) + ti) + fr; bias[BUF][ti] = bs[h * 128 + t]; \
                _Pragma("unroll") for (int kc = 0; kc <= (G); ++kc) wf[BUF][ti][kc] = *(const bf16x8*)(wsb + ((size_t)h * 128 + t) * 128 + 32 * kc + 8 * fq); } } while (0)
            LOADG(0, 0);
            asm volatile("s_waitcnt vmcnt(0)" ::: "memory");
#pragma unroll
            for (int g = 0; g < 4; ++g) {
                if (g < 3) LOADG((g + 1) & 1, g + 1);
                u32x4 ub[2][2];
#pragma unroll
                for (int ti = 0; ti < 2; ++ti)
#pragma unroll
                    for (int a2 = 0; a2 < 2; ++a2) ub[ti][a2] = *(const u32x4*)(proj + (size_t)(t0 + 16 * (2 * g + ti) + fr) * DP + CUG + 64 * h + 32 * a2 + 8 * fq);
                SBAR0();
                f32x4 acc[2][4];
#pragma unroll
                for (int ti = 0; ti < 2; ++ti)
#pragma unroll
                    for (int ct = 0; ct < 4; ++ct) { const float b = bias[g & 1][ti]; acc[ti][ct] = (f32x4){b, b, b, b}; }
#pragma unroll
                for (int kc = 0; kc <= g; ++kc) {
                    bf16x8 vf[4];
#pragma unroll
                    for (int ct = 0; ct < 4; ++ct) { const int ra = 32 * kc + 8 * fq + q4, c8 = 8 * (ct >> 1) + 2 * p4 + (ct & 1); vf[ct] = tr_frag(vl + vimg_off(ra, c8), vl + vimg_off(ra + 4, c8)); }
#pragma unroll
                    for (int ct = 0; ct < 4; ++ct)
#pragma unroll
                        for (int ti = 0; ti < 2; ++ti) acc[ti][ct] = MFMA16(vf[ct], wf[g & 1][ti][kc], acc[ti][ct]);
                }
#pragma unroll
                for (int ti = 0; ti < 2; ++ti)
#pragma unroll
                    for (int a2 = 0; a2 < 2; ++a2) {
                        const int t = 16 * (2 * g + ti) + fr; const u32x4 u = ub[ti][a2]; const f32x4 o0 = acc[ti][2 * a2], o1 = acc[ti][2 * a2 + 1];
                        u32x4 r; r.x = pg8::cvt_pk_bf16(o0[0] * bf_lo(u.x), o0[1] * bf_hi(u.x)); r.y = pg8::cvt_pk_bf16(o0[2] * bf_lo(u.y), o0[3] * bf_hi(u.y));
                        r.z = pg8::cvt_pk_bf16(o1[0] * bf_lo(u.z), o1[1] * bf_hi(u.z)); r.w = pg8::cvt_pk_bf16(o1[2] * bf_lo(u.w), o1[3] * bf_hi(u.w));
                        *(u32x4*)(mix + (size_t)(t0 + t) * DM + 1024 + 64 * h + 32 * a2 + 8 * fq) = r;
                    }
            }
#undef LOADG
        }
    }
}

#define XB_TMO      128
#define XB_XCNT(j)  (256  + 64 * (j))
#define XB_XSUB(j)  (1280 + 64 * (j))
#define XB_XGEN(j)  (2304 + 64 * (j))
#define XB_TOP      3328
#define XB_TOPGEN   3392
#define XCD_BAR_WORDS 3456
#define XB_SPIN_CAP (1u << 20)
__device__ __forceinline__ unsigned xb_ld(unsigned* p)              { return __hip_atomic_load(p, __ATOMIC_RELAXED, __HIP_MEMORY_SCOPE_AGENT); }
__device__ __forceinline__ unsigned xb_add(unsigned* p, unsigned v) { return __hip_atomic_fetch_add(p, v, __ATOMIC_RELAXED, __HIP_MEMORY_SCOPE_AGENT); }
__device__ __forceinline__ unsigned xb_xcc_id() { return (unsigned)__builtin_amdgcn_s_getreg((3 << 11) | 20) & 0xFu; }
#define XB_SPIN(cond, bar) do { unsigned _sp = 0; while (cond) { __builtin_amdgcn_s_sleep(1); \
    if ((++_sp & 255u) == 0u) { if (xb_ld(&(bar)[XB_TMO])) break; if (_sp > XB_SPIN_CAP) { atomicAdd(&(bar)[XB_TMO], 1u); break; } } } } while (0)
struct XcdBarrier { unsigned* bar; unsigned x; volatile LAS unsigned* st; };
__device__ __forceinline__ XcdBarrier xcd_barrier_post(unsigned* bar, volatile LAS unsigned* st) {
    XcdBarrier b; b.bar = bar; b.x = xb_xcc_id(); b.st = st;
    if (threadIdx.x == 0) (void)xb_add(&bar[XB_XCNT(b.x)], 1u);
    return b;
}
__device__ __forceinline__ void xcd_barrier_complete(unsigned* bar, unsigned x, unsigned& nloc, unsigned& nx) {
    const unsigned G = gridDim.x * gridDim.y * gridDim.z;
    unsigned sum, cnt, mine, sp = 0u;
    for (;;) {
        sum = 0u; cnt = 0u; mine = 0u;
#pragma unroll
        for (unsigned j = 0; j < 16; ++j) { const unsigned c = xb_ld(&bar[XB_XCNT(j)]); sum += c; cnt += (c > 0u) ? 1u : 0u; mine = (j == x) ? c : mine; }
        if (sum == G) break;
        __builtin_amdgcn_s_sleep(1);
        if ((++sp & 255u) == 0u) { if (xb_ld(&bar[XB_TMO])) break; if (sp > XB_SPIN_CAP) { atomicAdd(&bar[XB_TMO], 1u); break; } }
    }
    nloc = mine > 0u ? mine : 1u; nx = cnt > 0u ? cnt : 1u;
}
__device__ __forceinline__ void xcd_barrier(const XcdBarrier& b, bool thread0) {
    asm volatile("s_waitcnt vmcnt(0)" ::: "memory");
    __syncthreads();
    if (thread0) {
        unsigned* bar = b.bar;
        __builtin_amdgcn_s_waitcnt(0);
        unsigned nloc = b.st[0], nx = b.st[1];
        if (nloc == 0u) { xcd_barrier_complete(bar, b.x, nloc, nx); b.st[0] = nloc; b.st[1] = nx; }
        const unsigned old = xb_add(&bar[XB_XSUB(b.x)], 1u);
        const unsigned gen = old / nloc;
        if (old + 1u == (gen + 1u) * nloc) {
            __builtin_amdgcn_fence(__ATOMIC_RELEASE, "agent");
            asm volatile("s_waitcnt vmcnt(0)" ::: "memory");
            const unsigned og = xb_add(&bar[XB_TOP], 1u);
            const unsigned tg = og / nx;
            if (og + 1u == (tg + 1u) * nx) xb_add(&bar[XB_TOPGEN], 1u);
            else XB_SPIN(xb_ld(&bar[XB_TOPGEN]) == tg, bar);
            __builtin_amdgcn_fence(__ATOMIC_ACQUIRE, "agent");
            xb_add(&bar[XB_XGEN(b.x)], 1u);
            asm volatile("s_waitcnt vmcnt(0)" ::: "memory");
        } else {
            XB_SPIN(xb_ld(&bar[XB_XGEN(b.x)]) == gen, bar);
            __builtin_amdgcn_fence(__ATOMIC_ACQUIRE, "agent");
            asm volatile("s_waitcnt vmcnt(0)" ::: "memory");
        }
    }
    __syncthreads();
}

__global__ void __launch_bounds__(NWAVES * 64, 2) hybrid_fwd(Args a) {
    extern __shared__ __attribute__((aligned(16))) unsigned char lds_raw[];
    LAS unsigned char* lds = (LAS unsigned char*)lds_raw;
    cg::grid_group grid = cg::this_grid();
    const int tid = threadIdx.x, lane = tid & 63, wave = __builtin_amdgcn_readfirstlane(tid >> 6);
    unsigned char* ws = a.ws;
    bf16_t* xb = (bf16_t*)(ws + WS_XB); bf16_t* proj = (bf16_t*)(ws + WS_PROJ); bf16_t* mix = (bf16_t*)(ws + WS_MIX); float* rss = (float*)(ws + WS_RSS);

    volatile LAS unsigned* misc = (volatile LAS unsigned*)(lds + MISC_OFF);
    if (tid < 64) misc[tid] = 0u;
    if (blockIdx.x == 0) { unsigned* bw = (unsigned*)(ws + WS_BAR); for (int i = tid; i < XCD_BAR_WORDS; i += NWAVES * 64) bw[i] = 0u; }
    p0_prologue(a, lds, wave, lane);
    grid.sync();
    const XcdBarrier bar = xcd_barrier_post((unsigned*)(ws + WS_BAR), misc);
#define GRID_BAR() xcd_barrier(bar, wave == 0 && lane_id() == 0)
    for (int l = 0; l < DEPTH; ++l) {
        {
            pg8::Gemm g{xb, (const bf16_t*)(ws + WS_WIN + l * WIN_L), M, DIN, DM}; pg8::StaticOrder S; S.init(M, DIN, (int)gridDim.x, (int)blockIdx.x);
            pg8::EpiProj E{proj, rss + (size_t)l * M, a.q_norm + l * HD, a.k_norm + l * HD};
            for (int rep = 0; rep < REP_G1; ++rep) pg8::gemm_phase<pg8::EpiProj, pg8::StaticOrder>(lds, g, S, E, wave * 64 + lane_id());
        }
        GRID_BAR();
        for (int rep = 0; rep < REP_MIX; ++rep) {
        attn_mfma(proj, mix, a.sinks + l * 16, lds, wave, lane_id());
        sgu_mfma(proj, mix, (const bf16_t*)(ws + WS_WSB + l * WSB_L), a.b_s + l * 16 * 128, lds + wave * 18432, wave, lane_id());
        asm volatile("s_waitcnt vmcnt(0) lgkmcnt(0)" ::: "memory");
        }
        GRID_BAR();
        {
            pg8::Gemm g{mix, (const bf16_t*)(ws + WS_WOUT + l * WOUT_L), M, DM, DM}; pg8::StaticOrder S; S.init(M, DM, (int)gridDim.x, (int)blockIdx.x);
            float* rn = rss + (size_t)(l + 1 < DEPTH ? l + 1 : 0) * M;
            if (l == 0) { pg8::EpiRes<true, false> E{a.x, nullptr, xb, rn}; pg8::gemm_phase<pg8::EpiRes<true, false>, pg8::StaticOrder>(lds, g, S, E, wave * 64 + lane_id()); }
            else if (l + 1 < DEPTH) { pg8::EpiRes<false, false> E{nullptr, nullptr, xb, rn}; pg8::gemm_phase<pg8::EpiRes<false, false>, pg8::StaticOrder>(lds, g, S, E, wave * 64 + lane_id()); }
            else { pg8::EpiRes<false, true> E{nullptr, a.out, xb, nullptr}; pg8::gemm_phase<pg8::EpiRes<false, true>, pg8::StaticOrder>(lds, g, S, E, wave * 64 + lane_id()); }
        }
        if (l + 1 < DEPTH) GRID_BAR();
    }
}

extern "C" void kernel_launch(void* const* d_in, const int* in_sizes, int n_in, void* d_out, int out_size, void* d_ws, size_t ws_size, hipStream_t stream) {
    static int grid = 0;
    if (grid == 0) {
        if (n_in != 9 || in_sizes[0] != M * DM || out_size != M * DM || ws_size < WS_END) { fprintf(stderr, "kernel_launch: unexpected shapes / workspace (n_in %d, in0 %d, out %d, ws %zu < %zu)\n", n_in, n_in > 0 ? in_sizes[0] : -1, out_size, ws_size, (size_t)WS_END); grid = -1; return; }
        int dev = 0, cus = 0, per_cu = 0;
        hipGetDevice(&dev); hipDeviceGetAttribute(&cus, hipDeviceAttributeMultiprocessorCount, dev);
        if (hipFuncSetAttribute((const void*)hybrid_fwd, hipFuncAttributeMaxDynamicSharedMemorySize, LDS_BYTES) != hipSuccess) { fprintf(stderr, "kernel_launch: hipFuncSetAttribute failed\n"); grid = -1; return; }
        if (hipOccupancyMaxActiveBlocksPerMultiprocessor(&per_cu, (const void*)hybrid_fwd, NWAVES * 64, LDS_BYTES) != hipSuccess || per_cu < 1) { fprintf(stderr, "kernel_launch: occupancy query says %d\n", per_cu); per_cu = 1; }
        (void)hipGetLastError();
        grid = cus;
    }
    if (grid < 0) return;
    Args a{};
    a.x = (const float*)d_in[0]; a.norm_g = (const float*)d_in[1]; a.w_in = (const float*)d_in[2]; a.q_norm = (const float*)d_in[3]; a.k_norm = (const float*)d_in[4];
    a.sinks = (const float*)d_in[5]; a.w_s = (const float*)d_in[6]; a.b_s = (const float*)d_in[7]; a.w_out = (const float*)d_in[8];
    a.out = (float*)d_out; a.ws = (unsigned char*)d_ws;
    void* args[] = {&a};
    hipError_t e = hipLaunchCooperativeKernel((const void*)hybrid_fwd, dim3(grid), dim3(NWAVES * 64), args, LDS_BYTES, stream);
    if (e != hipSuccess) fprintf(stderr, "kernel_launch: cooperative launch failed: %s (grid %d)\n", hipGetErrorString(e), grid);
}
```

```cpp
#include <hip/hip_runtime.h>
#include <hip/hip_cooperative_groups.h>
#include <cstdio>
#include <cstdint>
namespace cg = cooperative_groups;

#define LAS __attribute__((address_space(3)))
typedef unsigned short bf16_t;
typedef short bf16x8 __attribute__((ext_vector_type(8)));
typedef float f32x4 __attribute__((ext_vector_type(4)));
typedef float f32x2 __attribute__((ext_vector_type(2)));
typedef unsigned u32x4 __attribute__((ext_vector_type(4)));
typedef unsigned u32x2 __attribute__((ext_vector_type(2)));

constexpr int BATCH = 4, SEQ = 8192, DM = 2048, DEPTH = 4, HD = 64;
constexpr int M = BATCH * SEQ;
constexpr int DIN = 5632;
constexpr int WU = 2560, WVS = 3584, WGB = 4608;
constexpr int DP = 4608;
constexpr int CQ = 0, CK = 1024, CV = 1280, CGA = 1536, CVS = 2560, CUG = 3584;
constexpr float RMS_EPS = 1e-6f;
constexpr float LOG2E = 1.4426950408889634f;
constexpr float QSCALE = 0.125f * LOG2E;

constexpr size_t WIN_L = (size_t)DIN * DM * 2, WOUT_L = (size_t)DM * DM * 2, WSB_L = (size_t)16 * 128 * 128 * 2;
constexpr size_t WS_WIN = 0;
constexpr size_t WS_WOUT = WS_WIN + DEPTH * WIN_L;
constexpr size_t WS_WSB = WS_WOUT + DEPTH * WOUT_L;
constexpr size_t WS_RSS = WS_WSB + DEPTH * WSB_L;
constexpr size_t WS_XB = WS_RSS + (size_t)DEPTH * M * 4;
constexpr size_t WS_PROJ = WS_XB + (size_t)M * DM * 2;
constexpr size_t WS_MIX = WS_PROJ + (size_t)M * DIN * 2;
constexpr size_t WS_BAR = WS_MIX + (size_t)M * DM * 2;
constexpr size_t WS_END = WS_BAR + 16384;

#define REP_MIX 1
#define PREFETCH_KQ 0
#define REP_G1 1
constexpr int NWAVES = 8;
constexpr int MISC_OFF = 147456;
constexpr int LDS_BYTES = 147456 + 256;

namespace pg8 {
constexpr int BM = 256, BK = 64, HALF = 128, HTB = HALF * BK * 2, STAGE_BYTES = 8 * HTB, NXCD = 8, WGM = 8;
__host__ __device__ __forceinline__ int lds_byte(int r, int c) { const int st = (r >> 4) * 2 + (c >> 5), rr = r & 15, cc = c & 31, ob = rr * 64 + cc * 2; return st * 1024 + (ob ^ (((ob >> 9) & 1) << 5)); }
__host__ __device__ __forceinline__ void stage_rc(int b, int& R, int& C) { const int st = b / 1024, sb = b % 1024, swz = sb ^ (((sb >> 9) & 1) << 5); R = (st >> 1) * 16 + swz / 64; C = (st & 1) * 32 + (swz % 64) / 2; }
__host__ __device__ __forceinline__ int perm32(int rho) { const int n = rho >> 4, i = rho & 15; return 8 * (i >> 2) + 4 * n + (i & 3); }

struct Unit { int pm, pn; };
struct Gemm { const bf16_t* A; const bf16_t* Bt; int M, N, K; };

struct StaticOrder {
    int nM, nN, nwg, G, c;
    __host__ __device__ void init(int M_, int N_, int G_, int c_) { nM = M_ / BM; nN = N_ / BM; nwg = nM * nN; G = G_; c = c_; }
    __host__ __device__ bool next(int i, Unit& u) const {
        const long L = (long)i * G + c; if (L >= nwg) return false;
        int wgid = (int)L; { const int q = nwg / NXCD, r = nwg % NXCD, xcd = wgid % NXCD, off = wgid / NXCD; wgid = (xcd < r ? xcd * (q + 1) : r * (q + 1) + (xcd - r) * q) + off; }
        const int nig = WGM * nN, gid = wgid / nig, fm = gid * WGM, gsz = (nM - fm) < WGM ? (nM - fm) : WGM;
        u.pm = fm + ((wgid % nig) % gsz); u.pn = (wgid % nig) / gsz; return true;
    }
};

__device__ __forceinline__ float bf_lo_(unsigned w) { return __uint_as_float(w << 16); }
__device__ __forceinline__ float bf_hi_(unsigned w) { return __uint_as_float(w & 0xffff0000u); }
typedef __bf16 bf16x2_t __attribute__((ext_vector_type(2)));
__device__ __forceinline__ unsigned cvt_pk_bf16(float lo, float hi) { const f32x2 v = {lo, hi}; const bf16x2_t b = __builtin_convertvector(v, bf16x2_t); return __builtin_bit_cast(unsigned, b); }
__device__ __forceinline__ f32x2 gelu_pk(f32x2 v) {
    f32x2 z = v * 0.70710678118f; z.x = __builtin_amdgcn_fmed3f(z.x, -3.0f, 3.0f); z.y = __builtin_amdgcn_fmed3f(z.y, -3.0f, 3.0f);
    const f32x2 t = (z * z) * 0.22222222222f + (-1.0f);
    f32x2 p = t * 1.277356223e-03f + (-3.382316293e-03f);
    p = p * t + 5.076752329e-03f; p = p * t + (-1.096681142e-02f); p = p * t + 2.438735024e-02f; p = p * t + (-4.437217044e-02f); p = p * t + 7.247759867e-02f;
    p = p * t + (-1.100018504e-01f); p = p * t + 1.575016831e-01f; p = p * t + (-2.288030019e-01f); p = p * t + 4.701317549e-01f;
    const f32x2 phi = (z * p) * 0.5f + 0.5f;
    return v * phi;
}
__device__ __forceinline__ float silu_f(float v) { return v * __builtin_amdgcn_rcpf(1.0f + __builtin_amdgcn_exp2f(-LOG2E * v)); }
__device__ __forceinline__ f32x4 gelu4(f32x4 v) { const f32x2 a = gelu_pk((f32x2){v[0], v[1]}), b = gelu_pk((f32x2){v[2], v[3]}); return (f32x4){a.x, a.y, b.x, b.y}; }
__device__ __forceinline__ f32x4 silu4(f32x4 v) { return (f32x4){silu_f(v[0]), silu_f(v[1]), silu_f(v[2]), silu_f(v[3])}; }
__device__ __forceinline__ u32x4 pack8(f32x4 v0, f32x4 v1) { u32x4 w; w.x = cvt_pk_bf16(v0[0], v0[1]); w.y = cvt_pk_bf16(v0[2], v0[3]); w.z = cvt_pk_bf16(v1[0], v1[1]); w.w = cvt_pk_bf16(v1[2], v1[3]); return w; }

__device__ __forceinline__ void glds16_(const void* gsrc, unsigned lds_dst) { unsigned keep;
    asm volatile("s_mov_b32 %0, m0\n\ts_mov_b32 m0, %2\n\ts_nop 0\n\tglobal_load_lds_dwordx4 %1, off\n\ts_mov_b32 m0, %0" : "=&s"(keep) : "v"(gsrc), "s"(lds_dst) : "memory"); }
constexpr int RSL_OFF = 131072;
struct EpiProj {
    static constexpr bool MIXED = true;
    bf16_t* O; const float* rss; const float* qn; const float* kn;
    template <int MODE> __device__ __forceinline__ void plain(const f32x4 (&acc)[2][2][4][2], const float (&rs)[2][4], bf16_t* base, int row0) const {
#pragma unroll
        for (int ai = 0; ai < 2; ++ai)
#pragma unroll
            for (int m = 0; m < 4; ++m) {
                bf16_t* rowp = base + (size_t)(row0 + ai * HALF + m * 16) * DP;
#pragma unroll
                for (int bj = 0; bj < 2; ++bj) { f32x4 v0 = acc[ai][bj][m][0] * rs[ai][m], v1 = acc[ai][bj][m][1] * rs[ai][m];
                    if (MODE == 2) { v0 = gelu4(v0); v1 = gelu4(v1); } else if (MODE == 1) { v0 = silu4(v0); v1 = silu4(v1); }
                    *(u32x4*)(rowp + bj * 32) = pack8(v0, v1); }
            }
    }
    static constexpr bool RSL = true;
    __device__ __forceinline__ const float* rss_panel(const Unit& u) const { return rss + u.pm * BM; }
    __device__ __forceinline__ void operator()(const f32x4 (&acc)[2][2][4][2], const Unit& u, int wr, int wc, int fr, int fq, const LAS float* rsl) const {
        const int row0 = u.pm * BM + wr * 64 + fr, pn = u.pn;
        float rs[2][4];
#pragma unroll
        for (int ai = 0; ai < 2; ++ai)
#pragma unroll
            for (int m = 0; m < 4; ++m) rs[ai][m] = rsl[wr * 64 + fr + ai * HALF + m * 16];
        f32x4 gv[2][2];
        if (pn < 5) { const float* gsrc = (pn < 4) ? qn : kn; const float sc = (pn < 4) ? QSCALE : 1.0f;
#pragma unroll
            for (int bj = 0; bj < 2; ++bj)
#pragma unroll
                for (int n = 0; n < 2; ++n) gv[bj][n] = *(const f32x4*)(gsrc + 32 * bj + 8 * fq + 4 * n) * sc; }
#pragma unroll
        for (int ai = 0; ai < 2; ++ai)
#pragma unroll
            for (int m = 0; m < 4; ++m) rs[ai][m] = rsqrtf(rs[ai][m] * (1.0f / DM) + RMS_EPS);
        if (pn >= 14) {
            bf16_t* base = O + CUG + (pn - 14) * 128 + wc * 32 + 8 * fq;
#pragma unroll
            for (int ai = 0; ai < 2; ++ai)
#pragma unroll
                for (int m = 0; m < 4; ++m) {
                    const f32x4 u0 = gelu4(acc[ai][0][m][0] * rs[ai][m]), u1 = gelu4(acc[ai][0][m][1] * rs[ai][m]);
                    const f32x4 g0 = silu4(acc[ai][1][m][0] * rs[ai][m]), g1 = silu4(acc[ai][1][m][1] * rs[ai][m]);
                    *(u32x4*)(base + (size_t)(row0 + ai * HALF + m * 16) * DP) = pack8(u0 * g0, u1 * g1);
                }
            return;
        }
        bf16_t* base = O + (pn < 10 ? pn * BM : CVS + (pn - 10) * BM) + wc * 64 + 8 * fq;
        if (pn < 5) {
#pragma unroll
            for (int ai = 0; ai < 2; ++ai)
#pragma unroll
                for (int m = 0; m < 4; ++m) {
                    f32x4 v[2][2]; float ss = 0.f;
#pragma unroll
                    for (int bj = 0; bj < 2; ++bj)
#pragma unroll
                        for (int n = 0; n < 2; ++n) { v[bj][n] = acc[ai][bj][m][n] * rs[ai][m]; const f32x4 x = v[bj][n]; ss += (x[0] * x[0] + x[1] * x[1]) + (x[2] * x[2] + x[3] * x[3]); }
                    ss += __shfl_xor(ss, 16); ss += __shfl_xor(ss, 32);
                    const float r = rsqrtf(ss * (1.0f / HD) + RMS_EPS);
                    bf16_t* rowp = base + (size_t)(row0 + ai * HALF + m * 16) * DP;
#pragma unroll
                    for (int bj = 0; bj < 2; ++bj) *(u32x4*)(rowp + bj * 32) = pack8(v[bj][0] * r * gv[bj][0], v[bj][1] * r * gv[bj][1]);
                }
        } else if (pn == 5) plain<0>(acc, rs, base, row0);
        else if (pn >= 10) plain<2>(acc, rs, base, row0);
        else plain<1>(acc, rs, base, row0);
    }
};
template <bool IN_F32, bool OUT_F32> struct EpiRes {
    static constexpr bool MIXED = false;
    static constexpr bool RSL = false;
    const float* xin; float* xout; bf16_t* xb; float* rss_next;
    __device__ __forceinline__ const float* rss_panel(const Unit&) const { return nullptr; }
    __device__ __forceinline__ void operator()(const f32x4 (&acc)[2][2][4][2], const Unit& u, int wr, int wc, int fr, int fq, const LAS float*) const {
        const int row0 = u.pm * BM + wr * 64 + fr; const int col0 = u.pn * BM + wc * 64 + 8 * fq;
        u32x4 xw[2][4][2];
        if (!IN_F32) {
#pragma unroll
            for (int ai = 0; ai < 2; ++ai)
#pragma unroll
                for (int m = 0; m < 4; ++m)
#pragma unroll
                    for (int bj = 0; bj < 2; ++bj) xw[ai][m][bj] = *(const u32x4*)(xb + (size_t)(row0 + ai * HALF + m * 16) * DM + col0 + bj * 32);
            __builtin_amdgcn_sched_barrier(0);
        }
#pragma unroll
        for (int ai = 0; ai < 2; ++ai) {
            f32x4 xv[4][2][2];
            if (IN_F32) {
#pragma unroll
                for (int m = 0; m < 4; ++m)
#pragma unroll
                    for (int bj = 0; bj < 2; ++bj) { const size_t off = (size_t)(row0 + ai * HALF + m * 16) * DM + col0 + bj * 32; xv[m][bj][0] = *(const f32x4*)(xin + off); xv[m][bj][1] = *(const f32x4*)(xin + off + 4); }
                __builtin_amdgcn_sched_barrier(0);
            }
#pragma unroll
            for (int m = 0; m < 4; ++m) {
                const int row = row0 + ai * HALF + m * 16; const size_t off = (size_t)row * DM + col0; float ss = 0.f;
#pragma unroll
                for (int bj = 0; bj < 2; ++bj) {
                    f32x4 b0, b1;
                    if (IN_F32) { b0 = xv[m][bj][0]; b1 = xv[m][bj][1]; }
                    else { const u32x4 w = xw[ai][m][bj]; b0 = (f32x4){bf_lo_(w.x), bf_hi_(w.x), bf_lo_(w.y), bf_hi_(w.y)}; b1 = (f32x4){bf_lo_(w.z), bf_hi_(w.z), bf_lo_(w.w), bf_hi_(w.w)}; }
                    const f32x4 v0 = acc[ai][bj][m][0] + b0, v1 = acc[ai][bj][m][1] + b1;
                    if (OUT_F32) { *(f32x4*)(xout + off + bj * 32) = v0; *(f32x4*)(xout + off + bj * 32 + 4) = v1; }
                    else {
                        ss += (v0[0] * v0[0] + v0[1] * v0[1]) + (v0[2] * v0[2] + v0[3] * v0[3]) + (v1[0] * v1[0] + v1[1] * v1[1]) + (v1[2] * v1[2] + v1[3] * v1[3]);
                        *(u32x4*)(xb + off + bj * 32) = pack8(v0, v1); }
                }
                if (!OUT_F32) { ss += __shfl_xor(ss, 16); ss += __shfl_xor(ss, 32); if (fq == 0) atomicAdd(rss_next + row, ss); }
            }
            __builtin_amdgcn_sched_barrier(0);
        }
    }
};

template <class Epi, class Sched>
__device__ __forceinline__ void gemm_phase(LAS unsigned char* lds, const Gemm g, const Sched& S, const Epi& E, int tid_in) {
    int tid_ = tid_in; asm volatile("" : "+v"(tid_));
    const int tid = tid_, wid = __builtin_amdgcn_readfirstlane(tid >> 6), lane = tid & 63, wr = wid >> 2, wc = wid & 3, fr = lane & 15, fq = lane >> 4;
    const int K = g.K, nt = K / BK;
    unsigned voffA[2], voffB[2];
#pragma unroll
    for (int i = 0; i < 2; ++i) { int R, C; stage_rc(tid * 16 + i * 8192, R, C); const int Rb = 64 * (R >> 5) + perm32(R & 31);
        voffA[i] = (unsigned)(R * K + C) * 2u; voffB[i] = (unsigned)(Rb * K + C) * 2u; }
    const size_t kstep = (size_t)(BK * 2);
    const size_t hstep = (size_t)HALF * K * 2;
    const size_t hstepB = (size_t)32 * K * 2;
    const size_t tstep = 2 * hstep;
    const size_t adjB0 = (size_t)(0 + (wid >> 2)) * 32 * K * 2, adjB1 = (size_t)(2 + (wid >> 2)) * 32 * K * 2;
#define PG8_BROW(pn) (Epi::MIXED ? ((pn) < 10 ? (pn) * BM : ((pn) < 14 ? WVS + ((pn) - 10) * BM : WU + ((pn) - 14) * 128)) : (pn) * BM)
#define PG8_ISMIX(pn) (Epi::MIXED && (pn) >= 14)
    const unsigned ldsw = (unsigned)wid * 1024u;
    const int aoff = lds_byte(wr * 64 + fr, fq * 8), boff = lds_byte(wc * 32 + fr, fq * 8);
#define PG8_SA(b, h) (((b) * 2 + (h)) * HTB)
#define PG8_SB(b, h) ((4 + (b) * 2 + (h)) * HTB)
#define PG8_STAGE(bufoff, gbase, voff) do { _Pragma("unroll") for (int _i = 0; _i < 2; ++_i) \
        __builtin_amdgcn_global_load_lds((const unsigned*)((const char*)(gbase) + (voff)[_i]), (LAS unsigned*)(lds + (bufoff) + ldsw + _i * 8192), 16, 0, 0); } while (0)
#define PG8_STAGEB(bufoff, gbase, mx) do { \
        __builtin_amdgcn_global_load_lds((const unsigned*)((const char*)(gbase) - ((mx) ? adjB0 : 0) + voffB[0]), (LAS unsigned*)(lds + (bufoff) + ldsw), 16, 0, 0); \
        __builtin_amdgcn_global_load_lds((const unsigned*)((const char*)(gbase) - ((mx) ? adjB1 : 0) + voffB[1]), (LAS unsigned*)(lds + (bufoff) + ldsw + 8192), 16, 0, 0); } while (0)
#define PG8_LDA(dst, b, h) do { _Pragma("unroll") for (int m = 0; m < 4; ++m) _Pragma("unroll") for (int k = 0; k < 2; ++k) dst[m][k] = *(const LAS bf16x8*)(lds + PG8_SA(b, h) + aoff + m * 2048 + k * 1024); } while (0)
#define PG8_LDB(dst, b, h) do { _Pragma("unroll") for (int n = 0; n < 2; ++n) _Pragma("unroll") for (int k = 0; k < 2; ++k) dst[n][k] = *(const LAS bf16x8*)(lds + PG8_SB(b, h) + boff + n * 2048 + k * 1024); } while (0)
#define PG8_MMA(ai, bj, At, Bt) do { __builtin_amdgcn_s_setprio(1); _Pragma("unroll") for (int m = 0; m < 4; ++m) _Pragma("unroll") for (int n = 0; n < 2; ++n) _Pragma("unroll") for (int k = 0; k < 2; ++k) \
        acc[ai][bj][m][n] = __builtin_amdgcn_mfma_f32_16x16x32_bf16(Bt[n][k], At[m][k], acc[ai][bj][m][n], 0, 0, 0); __builtin_amdgcn_s_setprio(0); } while (0)
#define PG8_WAIT_V(n) asm volatile("s_waitcnt vmcnt(" #n ")" ::: "memory")
#define PG8_WAIT_L(n) asm volatile("s_waitcnt lgkmcnt(" #n ")" ::: "memory")
#define PG8_BAR __builtin_amdgcn_s_barrier()
#define PG8_SCHED __builtin_amdgcn_sched_barrier(0)
    Unit cur, nxt; int ui = 0;
    if (!S.next(0, cur)) return;
    const unsigned rsl0 = (unsigned)(uintptr_t)(lds + RSL_OFF);
    if constexpr (Epi::RSL) { if (wid == 0) glds16_(E.rss_panel(cur) + lane * 4, (unsigned)__builtin_amdgcn_readfirstlane((int)rsl0)); }
    const char* cA = (const char*)g.A + (size_t)cur.pm * tstep; const char* cB = (const char*)g.Bt + (size_t)PG8_BROW(cur.pn) * K * 2;
    bool mc = PG8_ISMIX(cur.pn); size_t hbc = mc ? (size_t)(WGB - WU) * K * 2 : hstepB;
    PG8_STAGEB(PG8_SB(0, 0), cB, mc); PG8_STAGEB(PG8_SB(0, 1), cB + hbc, mc); PG8_STAGE(PG8_SA(0, 0), cA, voffA); PG8_STAGE(PG8_SA(0, 1), cA + hstep, voffA);
    if (wr == 1) PG8_BAR;
    PG8_WAIT_V(2); PG8_BAR;
    PG8_STAGEB(PG8_SB(1, 0), cB + kstep, mc); PG8_STAGE(PG8_SA(1, 0), cA + kstep, voffA); PG8_STAGEB(PG8_SB(1, 1), cB + hbc + kstep, mc);
    PG8_WAIT_V(6); PG8_BAR; PG8_SCHED;
    f32x4 acc[2][2][4][2];
#pragma unroll
    for (int a = 0; a < 2; ++a)
#pragma unroll
        for (int b = 0; b < 2; ++b)
#pragma unroll
            for (int m = 0; m < 4; ++m)
#pragma unroll
                for (int n = 0; n < 2; ++n) acc[a][b][m][n] = (f32x4){0.f, 0.f, 0.f, 0.f};
    bf16x8 At[4][2], B0[2][2], B1[2][2];
    for (;;) {
        const bool has_next = S.next(ui + 1, nxt);
        const char* nA = has_next ? (const char*)g.A + (size_t)nxt.pm * tstep : cA; const char* nB = has_next ? (const char*)g.Bt + (size_t)PG8_BROW(nxt.pn) * K * 2 : cB;
        const bool mn = has_next ? PG8_ISMIX(nxt.pn) : mc; const size_t hbn = mn ? (size_t)(WGB - WU) * K * 2 : hstepB;
        for (int t = 0; t < nt; t += 2) {
            const bool last = (t == nt - 2);
            const char* a1 = cA + (size_t)(t + 1) * kstep;
            const char* a2 = last ? nA : cA + (size_t)(t + 2) * kstep; const char* b2 = last ? nB : cB + (size_t)(t + 2) * kstep;
            const char* a3 = a2 + kstep; const char* b3 = b2 + kstep;
            const bool m2 = last ? mn : mc; const size_t hb2 = last ? hbn : hbc;
            PG8_LDB(B0, 0, 0); PG8_LDB(B1, 0, 1); PG8_SCHED; PG8_LDA(At, 0, 0); PG8_STAGE(PG8_SA(1, 1), a1 + hstep, voffA);
            PG8_WAIT_V(8); PG8_WAIT_L(0); PG8_BAR; PG8_MMA(0, 0, At, B0); PG8_MMA(0, 1, At, B1); PG8_BAR; PG8_SCHED;
            PG8_LDA(At, 0, 1); PG8_STAGEB(PG8_SB(0, 0), b2, m2); PG8_STAGEB(PG8_SB(0, 1), b2 + hb2, m2); PG8_STAGE(PG8_SA(0, 0), a2, voffA);
            PG8_WAIT_V(8); PG8_WAIT_L(0); PG8_BAR; PG8_MMA(1, 0, At, B0); PG8_MMA(1, 1, At, B1); PG8_BAR; PG8_SCHED;
            PG8_LDB(B0, 1, 0); PG8_LDB(B1, 1, 1); PG8_SCHED; PG8_LDA(At, 1, 0); PG8_STAGE(PG8_SA(0, 1), a2 + hstep, voffA);
            PG8_WAIT_V(8); PG8_WAIT_L(0); PG8_BAR; PG8_MMA(0, 0, At, B0); PG8_MMA(0, 1, At, B1); PG8_BAR; PG8_SCHED;
            PG8_LDA(At, 1, 1); PG8_STAGEB(PG8_SB(1, 0), b3, m2); PG8_STAGEB(PG8_SB(1, 1), b3 + hb2, m2); PG8_STAGE(PG8_SA(1, 0), a3, voffA);
            PG8_WAIT_V(8); PG8_WAIT_L(0); PG8_BAR; PG8_MMA(1, 0, At, B0); PG8_MMA(1, 1, At, B1); PG8_BAR; PG8_SCHED;
        }
        if (wr == 0) PG8_BAR;
        E(acc, cur, wr, wc, fr, fq, (const LAS float*)(lds + RSL_OFF + (ui & 1) * 1024));
        if (!has_next) break;
#pragma unroll
        for (int a = 0; a < 2; ++a)
#pragma unroll
            for (int b = 0; b < 2; ++b)
#pragma unroll
                for (int m = 0; m < 4; ++m)
#pragma unroll
                    for (int n = 0; n < 2; ++n) acc[a][b][m][n] = (f32x4){0.f, 0.f, 0.f, 0.f};
        cur = nxt; cA = nA; cB = nB; mc = mn; hbc = hbn; ++ui;
        if constexpr (Epi::RSL) { if (wid == 0) glds16_(E.rss_panel(cur) + lane * 4, (unsigned)__builtin_amdgcn_readfirstlane((int)(rsl0 + (ui & 1) * 1024))); }
        if (wr == 1) PG8_BAR;
    }
    PG8_WAIT_V(0);
    PG8_BAR;
#undef PG8_SA
#undef PG8_SB
#undef PG8_STAGE
#undef PG8_LDA
#undef PG8_STAGEB
#undef PG8_BROW
#undef PG8_ISMIX
#undef PG8_LDB
#undef PG8_MMA
#undef PG8_WAIT_V
#undef PG8_WAIT_L
#undef PG8_BAR
#undef PG8_SCHED
}
}

__device__ __forceinline__ unsigned f2bf(float f) { unsigned u = __builtin_bit_cast(unsigned, f); return (u + 0x7fffu + ((u >> 16) & 1u)) >> 16; }
__device__ __forceinline__ unsigned pk2(float lo, float hi) { return f2bf(lo) | (f2bf(hi) << 16); }
__device__ __forceinline__ float bf_lo(unsigned w) { return __uint_as_float(w << 16); }
__device__ __forceinline__ float bf_hi(unsigned w) { return __uint_as_float(w & 0xffff0000u); }
__device__ __forceinline__ float bf2f(bf16_t b) { return __uint_as_float((unsigned)b << 16); }
__device__ __forceinline__ float wave_sum(float v) {
#pragma unroll
    for (int o = 1; o < 64; o <<= 1) v += __shfl_xor(v, o);
    return v;
}

__device__ __forceinline__ int lane_id() { int r; asm volatile("v_mbcnt_lo_u32_b32 %0, -1, 0\n\tv_mbcnt_hi_u32_b32 %0, -1, %0" : "=v"(r)); return r; }

struct Args {
    const float* x; const float* norm_g; const float* w_in; const float* q_norm; const float* k_norm; const float* sinks; const float* w_s; const float* b_s; const float* w_out;
    float* out; unsigned char* ws;
};

__device__ __forceinline__ void p0_transpose_item(const float* W, int K, int N, bf16_t* WT, const float* gk, LAS float* scr, int item, int lane) {
    const int nblk = N / 64, kb = item / nblk, nb = item % nblk, k0 = 64 * kb, n0 = 64 * nb;
    const int r4 = lane >> 4, c4 = lane & 15;
    f32x4 v[16];
#pragma unroll
    for (int i = 0; i < 16; ++i) v[i] = __builtin_nontemporal_load((const f32x4*)(W + (size_t)(k0 + 4 * i + r4) * N + n0 + 4 * c4));
#pragma unroll
    for (int i = 0; i < 16; ++i) { LAS float* d = scr + (4 * i + r4) * 65 + 4 * c4; d[0] = v[i][0]; d[1] = v[i][1]; d[2] = v[i][2]; d[3] = v[i][3]; }
    asm volatile("s_waitcnt lgkmcnt(0)" ::: "memory");
    const int c = lane & 7, ns = lane >> 3;
    float gsc[8];
#pragma unroll
    for (int e = 0; e < 8; ++e) gsc[e] = gk ? gk[k0 + 8 * c + e] : 1.0f;
#pragma unroll
    for (int j = 0; j < 8; ++j) { const int n = 8 * j + ns; const LAS float* sp = scr + (8 * c) * 65 + n;
        u32x4 o; o.x = pk2(sp[0 * 65] * gsc[0], sp[1 * 65] * gsc[1]); o.y = pk2(sp[2 * 65] * gsc[2], sp[3 * 65] * gsc[3]); o.z = pk2(sp[4 * 65] * gsc[4], sp[5 * 65] * gsc[5]); o.w = pk2(sp[6 * 65] * gsc[6], sp[7 * 65] * gsc[7]);
        *(u32x4*)(WT + (size_t)(n0 + n) * K + k0 + 8 * c) = o; }
    asm volatile("s_waitcnt lgkmcnt(0)" ::: "memory");
}
__device__ __forceinline__ void p0_prologue(const Args& a, LAS unsigned char* lds, int wave, int lane) {
    LAS float* scr = (LAS float*)(lds + wave * 18432);
    const int gw = blockIdx.x * NWAVES + wave, NGW = gridDim.x * NWAVES;
    constexpr int I_IN = (DM / 64) * (DIN / 64), I_OUT = (DM / 64) * (DM / 64), I_L = I_IN + I_OUT;
    for (int it = gw; it < DEPTH * I_L; it += NGW) {
        const int l = it / I_L; int r = it % I_L;
        if (r < I_IN) p0_transpose_item(a.w_in + (size_t)l * DM * DIN, DM, DIN, (bf16_t*)(a.ws + WS_WIN + l * WIN_L), a.norm_g + l * DM, scr, r, lane);
        else p0_transpose_item(a.w_out + (size_t)l * DM * DM, DM, DM, (bf16_t*)(a.ws + WS_WOUT + l * WOUT_L), nullptr, scr, r - I_IN, lane);
    }
    { const int gt = blockIdx.x * (NWAVES * 64) + threadIdx.x, NT = gridDim.x * NWAVES * 64; bf16_t* wsb = (bf16_t*)(a.ws + WS_WSB);
      for (int i = gt; i < DEPTH * 16 * 128 * 128; i += NT) { const int s = i & 127, t = (i >> 7) & 127; wsb[i] = (s <= t) ? (bf16_t)f2bf(a.w_s[i]) : (bf16_t)0; }
      float* rss = (float*)(a.ws + WS_RSS);
      for (int i = gt; i < (DEPTH - 1) * M; i += NT) rss[M + i] = 0.f; }
    { float* rss = (float*)(a.ws + WS_RSS); bf16_t* xb = (bf16_t*)(a.ws + WS_XB);
      for (int m = gw; m < M; m += NGW) {
          const f32x4* xr = (const f32x4*)(a.x + (size_t)m * DM) + lane; u32x2* o = (u32x2*)(xb + (size_t)m * DM) + lane; float s = 0.f;
#pragma unroll
          for (int j = 0; j < 8; ++j) { const f32x4 v = __builtin_nontemporal_load(xr + 64 * j); s += (v[0] * v[0] + v[1] * v[1]) + (v[2] * v[2] + v[3] * v[3]); u32x2 w; w.x = pk2(v[0], v[1]); w.y = pk2(v[2], v[3]); o[64 * j] = w; }
          s = wave_sum(s); if (lane == 0) rss[m] = s; } }
}

typedef short v4i16_t __attribute__((ext_vector_type(4)));
__device__ __forceinline__ bf16x8 tr_frag(LAS unsigned char* pa, LAS unsigned char* pb) {
    const v4i16_t lo = __builtin_amdgcn_ds_read_tr16_b64_v4i16((LAS v4i16_t*)pa), hi = __builtin_amdgcn_ds_read_tr16_b64_v4i16((LAS v4i16_t*)pb);
    return __builtin_shufflevector(lo, hi, 0, 1, 2, 3, 4, 5, 6, 7);
}
__device__ __forceinline__ int vimg_off(int row, int c8) { return row * 128 + ((((c8 >> 1) ^ (((row >> 1) & 3) << 1))) << 4) + ((c8 & 1) << 3); }
#define MFMA16(x, y, c) __builtin_amdgcn_mfma_f32_16x16x32_bf16((x), (y), (c), 0, 0, 0)

#define SBAR0() __builtin_amdgcn_sched_barrier(0)
__device__ __forceinline__ void glds16(const void* gsrc, unsigned lds_dst) { unsigned keep;
    asm volatile("s_mov_b32 %0, m0\n\ts_mov_b32 m0, %2\n\ts_nop 0\n\tglobal_load_lds_dwordx4 %1, off\n\ts_mov_b32 m0, %0" : "=&s"(keep) : "v"(gsrc), "s"(lds_dst) : "memory"); }
__device__ __forceinline__ void attn_mfma(const bf16_t* proj, bf16_t* mix, const float* sinks, LAS unsigned char* lds, int wave, int lane_) {
    int lane = lane_; asm volatile("" : "+v"(lane));
    const int fr = lane & 15, fq = lane >> 4, q4 = (lane & 15) >> 2, p4 = lane & 3;
    for (int blk = blockIdx.x; blk < M / 128; blk += gridDim.x) {
        const int t0 = blk * 128; const bool first = (blk & (SEQ / 128 - 1)) == 0;
        const int tq = t0 + 16 * wave + fr;
        const bf16_t* qrow = proj + (size_t)tq * DP;
        const float sinkv = sinks[lane & 15] * LOG2E;
        const unsigned lds0 = (unsigned)(uintptr_t)lds;
#define DMA_KV(HK, BUF) do { _Pragma("unroll") for (int i4 = 0; i4 < 4; ++i4) { const int ii = 4 * wave + i4, rr = 8 * ii + (lane >> 3), k = (lane & 7) ^ (((rr >> 1) & 3) << 1); \
            int tok = t0 - 128 + rr; if (first && tok < t0) tok = t0; const bf16_t* src = proj + (size_t)tok * DP + 64 * (HK) + 8 * k; \
            glds16(src + CK, (unsigned)__builtin_amdgcn_readfirstlane((int)(lds0 + (BUF) * 65536 + ii * 1024))); \
            glds16(src + CV, (unsigned)__builtin_amdgcn_readfirstlane((int)(lds0 + (BUF) * 65536 + 32768 + ii * 1024))); } } while (0)
#define LOADQ(DST, HQ0) do { _Pragma("unroll") for (int g2 = 0; g2 < 2; ++g2) _Pragma("unroll") for (int s = 0; s < 2; ++s) DST[g2][s] = *(const bf16x8*)(qrow + CQ + 64 * ((HQ0) + g2) + 32 * s + 8 * fq); } while (0)
        asm volatile("s_waitcnt lgkmcnt(0)\n\ts_barrier" ::: "memory");
        DMA_KV(0, 0);
        bf16x8 qn[2][2];
        LOADQ(qn, 0);
        const int kro = 16 * wave + fr;
        const int kof0 = vimg_off(kro, 2 * fq), kof1 = vimg_off(kro, 2 * (4 + fq));
#pragma unroll 1
        for (int hk = 0; hk < 4; ++hk) {
            asm volatile("s_waitcnt vmcnt(0) lgkmcnt(0)\n\ts_barrier" ::: "memory");
            LAS unsigned char* kb = lds + (hk & 1) * 65536; LAS unsigned char* vb = kb + 32768;
#pragma unroll
            for (int gp = 0; gp < 2; ++gp) {
                const int hq0 = 4 * hk + 2 * gp;
                bf16x8 qf[2][2];
#pragma unroll
                for (int g2 = 0; g2 < 2; ++g2)
#pragma unroll
                    for (int s = 0; s < 2; ++s) qf[g2][s] = qn[g2][s];
                if (hq0 + 2 < 16) LOADQ(qn, hq0 + 2);
                u32x4 gav[2][2];
#pragma unroll
                for (int g2 = 0; g2 < 2; ++g2)
#pragma unroll
                    for (int a2 = 0; a2 < 2; ++a2) gav[g2][a2] = *(const u32x4*)(qrow + CGA + 64 * (hq0 + g2) + 32 * a2 + 8 * fq);
                float sref[2], sterm[2]; f32x4 cb[2]; float stp[2];
#pragma unroll
                for (int g2 = 0; g2 < 2; ++g2) {
                    const int hq = hq0 + g2; const float slope2 = exp2f(-0.5f * (float)(hq + 1)) * LOG2E, sink2 = __uint_as_float(__builtin_amdgcn_readlane(__float_as_uint(sinkv), hq));
                    sref[g2] = fminf(fmaxf(sink2, -60.f), 60.f); sterm[g2] = __builtin_amdgcn_exp2f(sink2 - sref[g2]); stp[g2] = slope2 * 16.0f;
                    const float b0 = slope2 * (float)(4 * fq - 128 - fr) - sref[g2];
                    cb[g2] = (f32x4){b0, b0 + slope2, b0 + 2.0f * slope2, b0 + 3.0f * slope2};
                }
                f32x4 S[2][9];
#pragma unroll
                for (int j = 0; j < 9; ++j) {
                    const bf16x8 k0 = *(const LAS bf16x8*)(kb + kof0 + j * 2048), k1 = *(const LAS bf16x8*)(kb + kof1 + j * 2048);
#pragma unroll
                    for (int g2 = 0; g2 < 2; ++g2) {
                        f32x4 c = cb[g2] + stp[g2] * (float)j;
                        if (j == 0) {
#pragma unroll
                            for (int i = 0; i < 4; ++i) c[i] = (4 * fq + i > fr) ? c[i] : -INFINITY; }
                        if (j == 8) {
#pragma unroll
                            for (int i = 0; i < 4; ++i) c[i] = (4 * fq + i <= fr) ? c[i] : -INFINITY; }
                        if (first && j < 8 - wave) c = (f32x4){-INFINITY, -INFINITY, -INFINITY, -INFINITY};
                        S[g2][j] = MFMA16(k0, qf[g2][0], c); S[g2][j] = MFMA16(k1, qf[g2][1], S[g2][j]); }
                }
                SBAR0();
                if (gp == 0 && hk < 3) { if (hk & 1) DMA_KV(hk + 1, 0); else DMA_KV(hk + 1, 1); }
                SBAR0();
                bf16x8 pf[2][5]; float il[2];
                const bf16x8 ones = {0x3F80, 0x3F80, 0x3F80, 0x3F80, 0x3F80, 0x3F80, 0x3F80, 0x3F80};
#pragma unroll
                for (int g2 = 0; g2 < 2; ++g2) {
                    f32x4 L = (f32x4){0.f, 0.f, 0.f, 0.f};
#pragma unroll
                    for (int c = 0; c < 5; ++c) { u32x4 w;
                        w.x = pg8::cvt_pk_bf16(__builtin_amdgcn_exp2f(S[g2][2 * c][0]), __builtin_amdgcn_exp2f(S[g2][2 * c][1])); w.y = pg8::cvt_pk_bf16(__builtin_amdgcn_exp2f(S[g2][2 * c][2]), __builtin_amdgcn_exp2f(S[g2][2 * c][3]));
                        if (c < 4) { w.z = pg8::cvt_pk_bf16(__builtin_amdgcn_exp2f(S[g2][2 * c + 1][0]), __builtin_amdgcn_exp2f(S[g2][2 * c + 1][1])); w.w = pg8::cvt_pk_bf16(__builtin_amdgcn_exp2f(S[g2][2 * c + 1][2]), __builtin_amdgcn_exp2f(S[g2][2 * c + 1][3])); } else { w.z = 0u; w.w = 0u; }
                        pf[g2][c] = __builtin_bit_cast(bf16x8, w);
                        L = MFMA16(ones, pf[g2][c], L); }
                    il[g2] = __builtin_amdgcn_rcpf(L[0] + sterm[g2]);
                }
                SBAR0();
                f32x4 O[2][4];
#pragma unroll
                for (int g2 = 0; g2 < 2; ++g2)
#pragma unroll
                    for (int dt = 0; dt < 4; ++dt) O[g2][dt] = (f32x4){0.f, 0.f, 0.f, 0.f};
#pragma unroll
                for (int c = 0; c < 5; ++c) {
                    bf16x8 vf[4];
#pragma unroll
                    for (int dt = 0; dt < 4; ++dt) { const int ra = 16 * wave + 32 * c + 4 * fq + q4, rb = (c < 4) ? ra + 16 : ra, c8 = 8 * (dt >> 1) + 2 * p4 + (dt & 1);
                        vf[dt] = tr_frag(vb + vimg_off(ra, c8), vb + vimg_off(rb, c8)); }
#pragma unroll
                    for (int dt = 0; dt < 4; ++dt)
#pragma unroll
                        for (int g2 = 0; g2 < 2; ++g2) O[g2][dt] = MFMA16(vf[dt], pf[g2][c], O[g2][dt]);
                }
#pragma unroll
                for (int g2 = 0; g2 < 2; ++g2)
#pragma unroll
                    for (int a2 = 0; a2 < 2; ++a2) {
                        const int col = 64 * (hq0 + g2) + 32 * a2 + 8 * fq; const u32x4 ga = gav[g2][a2];
                        const f32x4 o0 = O[g2][2 * a2] * il[g2], o1 = O[g2][2 * a2 + 1] * il[g2];
                        u32x4 r; r.x = pg8::cvt_pk_bf16(o0[0] * bf_lo(ga.x), o0[1] * bf_hi(ga.x)); r.y = pg8::cvt_pk_bf16(o0[2] * bf_lo(ga.y), o0[3] * bf_hi(ga.y));
                        r.z = pg8::cvt_pk_bf16(o1[0] * bf_lo(ga.z), o1[1] * bf_hi(ga.z)); r.w = pg8::cvt_pk_bf16(o1[2] * bf_lo(ga.w), o1[3] * bf_hi(ga.w));
                        *(u32x4*)(mix + (size_t)tq * DM + col) = r;
                    }
            }
        }
        asm volatile("s_waitcnt lgkmcnt(0)\n\ts_barrier" ::: "memory");
#undef DMA_KV
#undef LOADQ
    }
}
__device__ __forceinline__ void sgu_mfma(const bf16_t* proj, bf16_t* mix, const bf16_t* wsb, const float* bs, LAS unsigned char* vl, int wave, int lane_) {
    int lane = lane_; asm volatile("" : "+v"(lane));
    const int fr = lane & 15, fq = lane >> 4, q4 = (lane & 15) >> 2, p4 = lane & 3;
    for (int blk = blockIdx.x; blk < M / 128; blk += gridDim.x) {
        const int t0 = blk * 128;
#pragma unroll 1
        for (int hh = 0; hh < 2; ++hh) {
            const int h = wave + 8 * hh;
            asm volatile("s_waitcnt lgkmcnt(0)" ::: "memory");
#pragma unroll
            for (int ii = 0; ii < 16; ++ii) {
                const int rr = 8 * ii + (lane >> 3), k = (lane & 7) ^ (((rr >> 1) & 3) << 1);
                __builtin_amdgcn_global_load_lds((const unsigned*)(proj + (size_t)(t0 + rr) * DP + CVS + 64 * h + 8 * k), (LAS unsigned*)(vl + ii * 1024), 16, 0, 0);
            }
            bf16x8 wf[2][2][4]; float bias[2][2];
#define LOADG(BUF, G) do { _Pragma("unroll") for (int ti = 0; ti < 2; ++ti) { const int t = 16 * (2 * (G) + ti) + fr; bias[BUF][ti] = bs[h * 128 + t]; \
                _Pragma("unroll") for (int kc = 0; kc <= (G); ++kc) wf[BUF][ti][kc] = *(const bf16x8*)(wsb + ((size_t)h * 128 + t) * 128 + 32 * kc + 8 * fq); } } while (0)
            LOADG(0, 0);
            asm volatile("s_waitcnt vmcnt(0)" ::: "memory");
#pragma unroll
            for (int g = 0; g < 4; ++g) {
                if (g < 3) LOADG((g + 1) & 1, g + 1);
                u32x4 ub[2][2];
#pragma unroll
                for (int ti = 0; ti < 2; ++ti)
#pragma unroll
                    for (int a2 = 0; a2 < 2; ++a2) ub[ti][a2] = *(const u32x4*)(proj + (size_t)(t0 + 16 * (2 * g + ti) + fr) * DP + CUG + 64 * h + 32 * a2 + 8 * fq);
                SBAR0();
                f32x4 acc[2][4];
#pragma unroll
                for (int ti = 0; ti < 2; ++ti)
#pragma unroll
                    for (int ct = 0; ct < 4; ++ct) { const float b = bias[g & 1][ti]; acc[ti][ct] = (f32x4){b, b, b, b}; }
#pragma unroll
                for (int kc = 0; kc <= g; ++kc) {
                    bf16x8 vf[4];
#pragma unroll
                    for (int ct = 0; ct < 4; ++ct) { const int ra = 32 * kc + 8 * fq + q4, c8 = 8 * (ct >> 1) + 2 * p4 + (ct & 1); vf[ct] = tr_frag(vl + vimg_off(ra, c8), vl + vimg_off(ra + 4, c8)); }
#pragma unroll
                    for (int ct = 0; ct < 4; ++ct)
#pragma unroll
                        for (int ti = 0; ti < 2; ++ti) acc[ti][ct] = MFMA16(vf[ct], wf[g & 1][ti][kc], acc[ti][ct]);
                }
#pragma unroll
                for (int ti = 0; ti < 2; ++ti)
#pragma unroll
                    for (int a2 = 0; a2 < 2; ++a2) {
                        const int t = 16 * (2 * g + ti) + fr; const u32x4 u = ub[ti][a2]; const f32x4 o0 = acc[ti][2 * a2], o1 = acc[ti][2 * a2 + 1];
                        u32x4 r; r.x = pg8::cvt_pk_bf16(o0[0] * bf_lo(u.x), o0[1] * bf_hi(u.x)); r.y = pg8::cvt_pk_bf16(o0[2] * bf_lo(u.y), o0[3] * bf_hi(u.y));
                        r.z = pg8::cvt_pk_bf16(o1[0] * bf_lo(u.z), o1[1] * bf_hi(u.z)); r.w = pg8::cvt_pk_bf16(o1[2] * bf_lo(u.w), o1[3] * bf_hi(u.w));
                        *(u32x4*)(mix + (size_t)(t0 + t) * DM + 1024 + 64 * h + 32 * a2 + 8 * fq) = r;
                    }
            }
#undef LOADG
        }
    }
}

#define XB_TMO      128
#define XB_XCNT(j)  (256  + 64 * (j))
#define XB_XSUB(j)  (1280 + 64 * (j))
#define XB_XGEN(j)  (2304 + 64 * (j))
#define XB_TOP      3328
#define XB_TOPGEN   3392
#define XCD_BAR_WORDS 3456
#define XB_SPIN_CAP (1u << 20)
__device__ __forceinline__ unsigned xb_ld(unsigned* p)              { return __hip_atomic_load(p, __ATOMIC_RELAXED, __HIP_MEMORY_SCOPE_AGENT); }
__device__ __forceinline__ unsigned xb_add(unsigned* p, unsigned v) { return __hip_atomic_fetch_add(p, v, __ATOMIC_RELAXED, __HIP_MEMORY_SCOPE_AGENT); }
__device__ __forceinline__ unsigned xb_xcc_id() { return (unsigned)__builtin_amdgcn_s_getreg((3 << 11) | 20) & 0xFu; }
#define XB_SPIN(cond, bar) do { unsigned _sp = 0; while (cond) { __builtin_amdgcn_s_sleep(1); \
    if ((++_sp & 255u) == 0u) { if (xb_ld(&(bar)[XB_TMO])) break; if (_sp > XB_SPIN_CAP) { atomicAdd(&(bar)[XB_TMO], 1u); break; } } } } while (0)
struct XcdBarrier { unsigned* bar; unsigned x; volatile LAS unsigned* st; };
__device__ __forceinline__ XcdBarrier xcd_barrier_post(unsigned* bar, volatile LAS unsigned* st) {
    XcdBarrier b; b.bar = bar; b.x = xb_xcc_id(); b.st = st;
    if (threadIdx.x == 0) (void)xb_add(&bar[XB_XCNT(b.x)], 1u);
    return b;
}
__device__ __forceinline__ void xcd_barrier_complete(unsigned* bar, unsigned x, unsigned& nloc, unsigned& nx) {
    const unsigned G = gridDim.x * gridDim.y * gridDim.z;
    unsigned sum, cnt, mine, sp = 0u;
    for (;;) {
        sum = 0u; cnt = 0u; mine = 0u;
#pragma unroll
        for (unsigned j = 0; j < 16; ++j) { const unsigned c = xb_ld(&bar[XB_XCNT(j)]); sum += c; cnt += (c > 0u) ? 1u : 0u; mine = (j == x) ? c : mine; }
        if (sum == G) break;
        __builtin_amdgcn_s_sleep(1);
        if ((++sp & 255u) == 0u) { if (xb_ld(&bar[XB_TMO])) break; if (sp > XB_SPIN_CAP) { atomicAdd(&bar[XB_TMO], 1u); break; } }
    }
    nloc = mine > 0u ? mine : 1u; nx = cnt > 0u ? cnt : 1u;
}
__device__ __forceinline__ void xcd_barrier(const XcdBarrier& b, bool thread0) {
    asm volatile("s_waitcnt vmcnt(0)" ::: "memory");
    __syncthreads();
    if (thread0) {
        unsigned* bar = b.bar;
        __builtin_amdgcn_s_waitcnt(0);
        unsigned nloc = b.st[0], nx = b.st[1];
        if (nloc == 0u) { xcd_barrier_complete(bar, b.x, nloc, nx); b.st[0] = nloc; b.st[1] = nx; }
        const unsigned old = xb_add(&bar[XB_XSUB(b.x)], 1u);
        const unsigned gen = old / nloc;
        if (old + 1u == (gen + 1u) * nloc) {
            __builtin_amdgcn_fence(__ATOMIC_RELEASE, "agent");
            asm volatile("s_waitcnt vmcnt(0)" ::: "memory");
            const unsigned og = xb_add(&bar[XB_TOP], 1u);
            const unsigned tg = og / nx;
            if (og + 1u == (tg + 1u) * nx) xb_add(&bar[XB_TOPGEN], 1u);
            else XB_SPIN(xb_ld(&bar[XB_TOPGEN]) == tg, bar);
            __builtin_amdgcn_fence(__ATOMIC_ACQUIRE, "agent");
            xb_add(&bar[XB_XGEN(b.x)], 1u);
            asm volatile("s_waitcnt vmcnt(0)" ::: "memory");
        } else {
            XB_SPIN(xb_ld(&bar[XB_XGEN(b.x)]) == gen, bar);
            __builtin_amdgcn_fence(__ATOMIC_ACQUIRE, "agent");
            asm volatile("s_waitcnt vmcnt(0)" ::: "memory");
        }
    }
    __syncthreads();
}

__global__ void __launch_bounds__(NWAVES * 64, 2) hybrid_fwd(Args a) {
    extern __shared__ __attribute__((aligned(16))) unsigned char lds_raw[];
    LAS unsigned char* lds = (LAS unsigned char*)lds_raw;
    cg::grid_group grid = cg::this_grid();
    const int tid = threadIdx.x, lane = tid & 63, wave = __builtin_amdgcn_readfirstlane(tid >> 6);
    unsigned char* ws = a.ws;
    bf16_t* xb = (bf16_t*)(ws + WS_XB); bf16_t* proj = (bf16_t*)(ws + WS_PROJ); bf16_t* mix = (bf16_t*)(ws + WS_MIX); float* rss = (float*)(ws + WS_RSS);

    volatile LAS unsigned* misc = (volatile LAS unsigned*)(lds + MISC_OFF);
    if (tid < 64) misc[tid] = 0u;
    if (blockIdx.x == 0) { unsigned* bw = (unsigned*)(ws + WS_BAR); for (int i = tid; i < XCD_BAR_WORDS; i += NWAVES * 64) bw[i] = 0u; }
    p0_prologue(a, lds, wave, lane);
    grid.sync();
    const XcdBarrier bar = xcd_barrier_post((unsigned*)(ws + WS_BAR), misc);
#define GRID_BAR() xcd_barrier(bar, wave == 0 && lane_id() == 0)
    for (int l = 0; l < DEPTH; ++l) {
        {
            pg8::Gemm g{xb, (const bf16_t*)(ws + WS_WIN + l * WIN_L), M, DIN, DM}; pg8::StaticOrder S; S.init(M, DIN, (int)gridDim.x, (int)blockIdx.x);
            pg8::EpiProj E{proj, rss + (size_t)l * M, a.q_norm + l * HD, a.k_norm + l * HD};
            for (int rep = 0; rep < REP_G1; ++rep) pg8::gemm_phase<pg8::EpiProj, pg8::StaticOrder>(lds, g, S, E, wave * 64 + lane_id());
        }
        GRID_BAR();
        for (int rep = 0; rep < REP_MIX; ++rep) {
        attn_mfma(proj, mix, a.sinks + l * 16, lds, wave, lane_id());
        sgu_mfma(proj, mix, (const bf16_t*)(ws + WS_WSB + l * WSB_L), a.b_s + l * 16 * 128, lds + wave * 18432, wave, lane_id());
        asm volatile("s_waitcnt vmcnt(0) lgkmcnt(0)" ::: "memory");
        }
        GRID_BAR();
        {
            pg8::Gemm g{mix, (const bf16_t*)(ws + WS_WOUT + l * WOUT_L), M, DM, DM}; pg8::StaticOrder S; S.init(M, DM, (int)gridDim.x, (int)blockIdx.x);
            float* rn = rss + (size_t)(l + 1 < DEPTH ? l + 1 : 0) * M;
            if (l == 0) { pg8::EpiRes<true, false> E{a.x, nullptr, xb, rn}; pg8::gemm_phase<pg8::EpiRes<true, false>, pg8::StaticOrder>(lds, g, S, E, wave * 64 + lane_id()); }
            else if (l + 1 < DEPTH) { pg8::EpiRes<false, false> E{nullptr, nullptr, xb, rn}; pg8::gemm_phase<pg8::EpiRes<false, false>, pg8::StaticOrder>(lds, g, S, E, wave * 64 + lane_id()); }
            else { pg8::EpiRes<false, true> E{nullptr, a.out, xb, nullptr}; pg8::gemm_phase<pg8::EpiRes<false, true>, pg8::StaticOrder>(lds, g, S, E, wave * 64 + lane_id()); }
        }
        if (l + 1 < DEPTH) GRID_BAR();
    }
}

extern "C" void kernel_launch(void* const* d_in, const int* in_sizes, int n_in, void* d_out, int out_size, void* d_ws, size_t ws_size, hipStream_t stream) {
    static int grid = 0;
    if (grid == 0) {
        if (n_in != 9 || in_sizes[0] != M * DM || out_size != M * DM || ws_size < WS_END) { fprintf(stderr, "kernel_launch: unexpected shapes / workspace (n_in %d, in0 %d, out %d, ws %zu < %zu)\n", n_in, n_in > 0 ? in_sizes[0] : -1, out_size, ws_size, (size_t)WS_END); grid = -1; return; }
        int dev = 0, cus = 0, per_cu = 0;
        hipGetDevice(&dev); hipDeviceGetAttribute(&cus, hipDeviceAttributeMultiprocessorCount, dev);
        if (hipFuncSetAttribute((const void*)hybrid_fwd, hipFuncAttributeMaxDynamicSharedMemorySize, LDS_BYTES) != hipSuccess) { fprintf(stderr, "kernel_launch: hipFuncSetAttribute failed\n"); grid = -1; return; }
        if (hipOccupancyMaxActiveBlocksPerMultiprocessor(&per_cu, (const void*)hybrid_fwd, NWAVES * 64, LDS_BYTES) != hipSuccess || per_cu < 1) { fprintf(stderr, "kernel_launch: occupancy query says %d\n", per_cu); per_cu = 1; }
        (void)hipGetLastError();
        grid = cus;
    }
    if (grid < 0) return;
    Args a{};
    a.x = (const float*)d_in[0]; a.norm_g = (const float*)d_in[1]; a.w_in = (const float*)d_in[2]; a.q_norm = (const float*)d_in[3]; a.k_norm = (const float*)d_in[4];
    a.sinks = (const float*)d_in[5]; a.w_s = (const float*)d_in[6]; a.b_s = (const float*)d_in[7]; a.w_out = (const float*)d_in[8];
    a.out = (float*)d_out; a.ws = (unsigned char*)d_ws;
    void* args[] = {&a};
    hipError_t e = hipLaunchCooperativeKernel((const void*)hybrid_fwd, dim3(grid), dim3(NWAVES * 64), args, LDS_BYTES, stream);
    if (e != hipSuccess) fprintf(stderr, "kernel_launch: cooperative launch failed: %s (grid %d)\n", hipGetErrorString(e), grid);
}
```

```cpp
#include <hip/hip_runtime.h>
#include <hip/hip_cooperative_groups.h>
#include <cstdio>
#include <cstdint>
namespace cg = cooperative_groups;

#define LAS __attribute__((address_space(3)))
typedef unsigned short bf16_t;
typedef short bf16x8 __attribute__((ext_vector_type(8)));
typedef float f32x4 __attribute__((ext_vector_type(4)));
typedef float f32x2 __attribute__((ext_vector_type(2)));
typedef unsigned u32x4 __attribute__((ext_vector_type(4)));
typedef unsigned u32x2 __attribute__((ext_vector_type(2)));

constexpr int BATCH = 4, SEQ = 8192, DM = 2048, DEPTH = 4, HD = 64;
constexpr int M = BATCH * SEQ;
constexpr int DIN = 5632;
constexpr int WU = 2560, WVS = 3584, WGB = 4608;
constexpr int DP = 4608;
constexpr int CQ = 0, CK = 1024, CV = 1280, CGA = 1536, CVS = 2560, CUG = 3584;
constexpr float RMS_EPS = 1e-6f;
constexpr float LOG2E = 1.4426950408889634f;
constexpr float QSCALE = 0.125f * LOG2E;

constexpr size_t WIN_L = (size_t)DIN * DM * 2, WOUT_L = (size_t)DM * DM * 2, WSB_L = (size_t)16 * 128 * 128 * 2;
constexpr size_t WS_WIN = 0;
constexpr size_t WS_WOUT = WS_WIN + DEPTH * WIN_L;
constexpr size_t WS_WSB = WS_WOUT + DEPTH * WOUT_L;
constexpr size_t WS_RSS = WS_WSB + DEPTH * WSB_L;
constexpr size_t WS_XB = WS_RSS + (size_t)DEPTH * M * 4;
constexpr size_t WS_PROJ = WS_XB + (size_t)M * DM * 2;
constexpr size_t WS_MIX = WS_PROJ + (size_t)M * DIN * 2;
constexpr size_t WS_BAR = WS_MIX + (size_t)M * DM * 2;
constexpr size_t WS_END = WS_BAR + 16384;

#define REP_MIX 1
#define PREFETCH_KQ 0
#define REP_G1 1
constexpr int NWAVES = 8;
constexpr int MISC_OFF = 147456;
constexpr int LDS_BYTES = 147456 + 256;

namespace pg8 {
constexpr int BM = 256, BK = 64, HALF = 128, HTB = HALF * BK * 2, STAGE_BYTES = 8 * HTB, NXCD = 8, WGM = 8;
__host__ __device__ __forceinline__ int lds_byte(int r, int c) { const int st = (r >> 4) * 2 + (c >> 5), rr = r & 15, cc = c & 31, ob = rr * 64 + cc * 2; return st * 1024 + (ob ^ (((ob >> 9) & 1) << 5)); }
__host__ __device__ __forceinline__ void stage_rc(int b, int& R, int& C) { const int st = b / 1024, sb = b % 1024, swz = sb ^ (((sb >> 9) & 1) << 5); R = (st >> 1) * 16 + swz / 64; C = (st & 1) * 32 + (swz % 64) / 2; }
__host__ __device__ __forceinline__ int perm32(int rho) { const int n = rho >> 4, i = rho & 15; return 8 * (i >> 2) + 4 * n + (i & 3); }

struct Unit { int pm, pn; };
struct Gemm { const bf16_t* A; const bf16_t* Bt; int M, N, K; };

struct StaticOrder {
    int nM, nN, nwg, G, c;
    __host__ __device__ void init(int M_, int N_, int G_, int c_) { nM = M_ / BM; nN = N_ / BM; nwg = nM * nN; G = G_; c = c_; }
    __host__ __device__ bool next(int i, Unit& u) const {
        const long L = (long)i * G + c; if (L >= nwg) return false;
        int wgid = (int)L; { const int q = nwg / NXCD, r = nwg % NXCD, xcd = wgid % NXCD, off = wgid / NXCD; wgid = (xcd < r ? xcd * (q + 1) : r * (q + 1) + (xcd - r) * q) + off; }
        const int nig = WGM * nN, gid = wgid / nig, fm = gid * WGM, gsz = (nM - fm) < WGM ? (nM - fm) : WGM;
        u.pm = fm + ((wgid % nig) % gsz); u.pn = (wgid % nig) / gsz; return true;
    }
};

__device__ __forceinline__ float bf_lo_(unsigned w) { return __uint_as_float(w << 16); }
__device__ __forceinline__ float bf_hi_(unsigned w) { return __uint_as_float(w & 0xffff0000u); }
typedef __bf16 bf16x2_t __attribute__((ext_vector_type(2)));
__device__ __forceinline__ unsigned cvt_pk_bf16(float lo, float hi) { const f32x2 v = {lo, hi}; const bf16x2_t b = __builtin_convertvector(v, bf16x2_t); return __builtin_bit_cast(unsigned, b); }
__device__ __forceinline__ f32x2 gelu_pk(f32x2 v) {
    f32x2 z = v * 0.70710678118f; z.x = __builtin_amdgcn_fmed3f(z.x, -3.0f, 3.0f); z.y = __builtin_amdgcn_fmed3f(z.y, -3.0f, 3.0f);
    const f32x2 t = (z * z) * 0.22222222222f + (-1.0f);
    f32x2 p = t * 1.277356223e-03f + (-3.382316293e-03f);
    p = p * t + 5.076752329e-03f; p = p * t + (-1.096681142e-02f); p = p * t + 2.438735024e-02f; p = p * t + (-4.437217044e-02f); p = p * t + 7.247759867e-02f;
    p = p * t + (-1.100018504e-01f); p = p * t + 1.575016831e-01f; p = p * t + (-2.288030019e-01f); p = p * t + 4.701317549e-01f;
    const f32x2 phi = (z * p) * 0.5f + 0.5f;
    return v * phi;
}
__device__ __forceinline__ float silu_f(float v) { return v * __builtin_amdgcn_rcpf(1.0f + __builtin_amdgcn_exp2f(-LOG2E * v)); }
__device__ __forceinline__ f32x4 gelu4(f32x4 v) { const f32x2 a = gelu_pk((f32x2){v[0], v[1]}), b = gelu_pk((f32x2){v[2], v[3]}); return (f32x4){a.x, a.y, b.x, b.y}; }
__device__ __forceinline__ f32x4 silu4(f32x4 v) { return (f32x4){silu_f(v[0]), silu_f(v[1]), silu_f(v[2]), silu_f(v[3])}; }
__device__ __forceinline__ u32x4 pack8(f32x4 v0, f32x4 v1) { u32x4 w; w.x = cvt_pk_bf16(v0[0], v0[1]); w.y = cvt_pk_bf16(v0[2], v0[3]); w.z = cvt_pk_bf16(v1[0], v1[1]); w.w = cvt_pk_bf16(v1[2], v1[3]); return w; }

__device__ __forceinline__ void glds16_(const void* gsrc, unsigned lds_dst) { unsigned keep;
    asm volatile("s_mov_b32 %0, m0\n\ts_mov_b32 m0, %2\n\ts_nop 0\n\tglobal_load_lds_dwordx4 %1, off\n\ts_mov_b32 m0, %0" : "=&s"(keep) : "v"(gsrc), "s"(lds_dst) : "memory"); }
constexpr int RSL_OFF = 131072;
struct EpiProj {
    static constexpr bool MIXED = true;
    bf16_t* O; const float* rss; const float* qn; const float* kn;
    template <int MODE> __device__ __forceinline__ void plain(const f32x4 (&acc)[2][2][4][2], const float (&rs)[2][4], bf16_t* base, int row0) const {
#pragma unroll
        for (int ai = 0; ai < 2; ++ai)
#pragma unroll
            for (int m = 0; m < 4; ++m) {
                bf16_t* rowp = base + (size_t)(row0 + ai * HALF + m * 16) * DP;
#pragma unroll
                for (int bj = 0; bj < 2; ++bj) { f32x4 v0 = acc[ai][bj][m][0] * rs[ai][m], v1 = acc[ai][bj][m][1] * rs[ai][m];
                    if (MODE == 2) { v0 = gelu4(v0); v1 = gelu4(v1); } else if (MODE == 1) { v0 = silu4(v0); v1 = silu4(v1); }
                    *(u32x4*)(rowp + bj * 32) = pack8(v0, v1); }
            }
    }
    static constexpr bool RSL = true;
    __device__ __forceinline__ const float* rss_panel(const Unit& u) const { return rss + u.pm * BM; }
    __device__ __forceinline__ void operator()(const f32x4 (&acc)[2][2][4][2], const Unit& u, int wr, int wc, int fr, int fq, const LAS float* rsl) const {
        const int row0 = u.pm * BM + wr * 64 + fr, pn = u.pn;
        float rs[2][4];
#pragma unroll
        for (int ai = 0; ai < 2; ++ai)
#pragma unroll
            for (int m = 0; m < 4; ++m) rs[ai][m] = rsl[wr * 64 + fr + ai * HALF + m * 16];
        f32x4 gv[2][2];
        if (pn < 5) { const float* gsrc = (pn < 4) ? qn : kn; const float sc = (pn < 4) ? QSCALE : 1.0f;
#pragma unroll
            for (int bj = 0; bj < 2; ++bj)
#pragma unroll
                for (int n = 0; n < 2; ++n) gv[bj][n] = *(const f32x4*)(gsrc + 32 * bj + 8 * fq + 4 * n) * sc; }
#pragma unroll
        for (int ai = 0; ai < 2; ++ai)
#pragma unroll
            for (int m = 0; m < 4; ++m) rs[ai][m] = rsqrtf(rs[ai][m] * (1.0f / DM) + RMS_EPS);
        if (pn >= 14) {
            bf16_t* base = O + CUG + (pn - 14) * 128 + wc * 32 + 8 * fq;
#pragma unroll
            for (int ai = 0; ai < 2; ++ai)
#pragma unroll
                for (int m = 0; m < 4; ++m) {
                    const f32x4 u0 = gelu4(acc[ai][0][m][0] * rs[ai][m]), u1 = gelu4(acc[ai][0][m][1] * rs[ai][m]);
                    const f32x4 g0 = silu4(acc[ai][1][m][0] * rs[ai][m]), g1 = silu4(acc[ai][1][m][1] * rs[ai][m]);
                    *(u32x4*)(base + (size_t)(row0 + ai * HALF + m * 16) * DP) = pack8(u0 * g0, u1 * g1);
                }
            return;
        }
        bf16_t* base = O + (pn < 10 ? pn * BM : CVS + (pn - 10) * BM) + wc * 64 + 8 * fq;
        if (pn < 5) {
#pragma unroll
            for (int ai = 0; ai < 2; ++ai)
#pragma unroll
                for (int m = 0; m < 4; ++m) {
                    f32x4 v[2][2]; float ss = 0.f;
#pragma unroll
                    for (int bj = 0; bj < 2; ++bj)
#pragma unroll
                        for (int n = 0; n < 2; ++n) { v[bj][n] = acc[ai][bj][m][n] * rs[ai][m]; const f32x4 x = v[bj][n]; ss += (x[0] * x[0] + x[1] * x[1]) + (x[2] * x[2] + x[3] * x[3]); }
                    ss += __shfl_xor(ss, 16); ss += __shfl_xor(ss, 32);
                    const float r = rsqrtf(ss * (1.0f / HD) + RMS_EPS);
                    bf16_t* rowp = base + (size_t)(row0 + ai * HALF + m * 16) * DP;
#pragma unroll
                    for (int bj = 0; bj < 2; ++bj) *(u32x4*)(rowp + bj * 32) = pack8(v[bj][0] * r * gv[bj][0], v[bj][1] * r * gv[bj][1]);
                }
        } else if (pn == 5) plain<0>(acc, rs, base, row0);
        else if (pn >= 10) plain<2>(acc, rs, base, row0);
        else plain<1>(acc, rs, base, row0);
    }
};
template <bool IN_F32, bool OUT_F32> struct EpiRes {
    static constexpr bool MIXED = false;
    static constexpr bool RSL = false;
    const float* xin; float* xout; bf16_t* xb; float* rss_next;
    __device__ __forceinline__ const float* rss_panel(const Unit&) const { return nullptr; }
    __device__ __forceinline__ void operator()(const f32x4 (&acc)[2][2][4][2], const Unit& u, int wr, int wc, int fr, int fq, const LAS float*) const {
        const int row0 = u.pm * BM + wr * 64 + fr; const int col0 = u.pn * BM + wc * 64 + 8 * fq;
        u32x4 xw[2][4][2];
        if (!IN_F32) {
#pragma unroll
            for (int ai = 0; ai < 2; ++ai)
#pragma unroll
                for (int m = 0; m < 4; ++m)
#pragma unroll
                    for (int bj = 0; bj < 2; ++bj) xw[ai][m][bj] = *(const u32x4*)(xb + (size_t)(row0 + ai * HALF + m * 16) * DM + col0 + bj * 32);
            __builtin_amdgcn_sched_barrier(0);
        }
#pragma unroll
        for (int ai = 0; ai < 2; ++ai) {
            f32x4 xv[4][2][2];
            if (IN_F32) {
#pragma unroll
                for (int m = 0; m < 4; ++m)
#pragma unroll
                    for (int bj = 0; bj < 2; ++bj) { const size_t off = (size_t)(row0 + ai * HALF + m * 16) * DM + col0 + bj * 32; xv[m][bj][0] = *(const f32x4*)(xin + off); xv[m][bj][1] = *(const f32x4*)(xin + off + 4); }
                __builtin_amdgcn_sched_barrier(0);
            }
#pragma unroll
            for (int m = 0; m < 4; ++m) {
                const int row = row0 + ai * HALF + m * 16; const size_t off = (size_t)row * DM + col0; float ss = 0.f;
#pragma unroll
                for (int bj = 0; bj < 2; ++bj) {
                    f32x4 b0, b1;
                    if (IN_F32) { b0 = xv[m][bj][0]; b1 = xv[m][bj][1]; }
                    else { const u32x4 w = xw[ai][m][bj]; b0 = (f32x4){bf_lo_(w.x), bf_hi_(w.x), bf_lo_(w.y), bf_hi_(w.y)}; b1 = (f32x4){bf_lo_(w.z), bf_hi_(w.z), bf_lo_(w.w), bf_hi_(w.w)}; }
                    const f32x4 v0 = acc[ai][bj][m][0] + b0, v1 = acc[ai][bj][m][1] + b1;
                    if (OUT_F32) { *(f32x4*)(xout + off + bj * 32) = v0; *(f32x4*)(xout + off + bj * 32 + 4) = v1; }
                    else {
                        ss += (v0[0] * v0[0] + v0[1] * v0[1]) + (v0[2] * v0[2] + v0[3] * v0[3]) + (v1[0] * v1[0] + v1[1] * v1[1]) + (v1[2] * v1[2] + v1[3] * v1[3]);
                        *(u32x4*)(xb + off + bj * 32) = pack8(v0, v1); }
                }
                if (!OUT_F32) { ss += __shfl_xor(ss, 16); ss += __shfl_xor(ss, 32); if (fq == 0) atomicAdd(rss_next + row, ss); }
            }
            __builtin_amdgcn_sched_barrier(0);
        }
    }
};

template <class Epi, class Sched>
__device__ __forceinline__ void gemm_phase(LAS unsigned char* lds, const Gemm g, const Sched& S, const Epi& E, int tid_in) {
    int tid_ = tid_in; asm volatile("" : "+v"(tid_));
    const int tid = tid_, wid = __builtin_amdgcn_readfirstlane(tid >> 6), lane = tid & 63, wr = wid >> 2, wc = wid & 3, fr = lane & 15, fq = lane >> 4;
    const int K = g.K, nt = K / BK;
    unsigned voffA[2], voffB[2];
#pragma unroll
    for (int i = 0; i < 2; ++i) { int R, C; stage_rc(tid * 16 + i * 8192, R, C); const int Rb = 64 * (R >> 5) + perm32(R & 31);
        voffA[i] = (unsigned)(R * K + C) * 2u; voffB[i] = (unsigned)(Rb * K + C) * 2u; }
    const size_t kstep = (size_t)(BK * 2);
    const size_t hstep = (size_t)HALF * K * 2;
    const size_t hstepB = (size_t)32 * K * 2;
    const size_t tstep = 2 * hstep;
    const size_t adjB0 = (size_t)(0 + (wid >> 2)) * 32 * K * 2, adjB1 = (size_t)(2 + (wid >> 2)) * 32 * K * 2;
#define PG8_BROW(pn) (Epi::MIXED ? ((pn) < 10 ? (pn) * BM : ((pn) < 14 ? WVS + ((pn) - 10) * BM : WU + ((pn) - 14) * 128)) : (pn) * BM)
#define PG8_ISMIX(pn) (Epi::MIXED && (pn) >= 14)
    const unsigned ldsw = (unsigned)wid * 1024u;
    const int aoff = lds_byte(wr * 64 + fr, fq * 8), boff = lds_byte(wc * 32 + fr, fq * 8);
#define PG8_SA(b, h) (((b) * 2 + (h)) * HTB)
#define PG8_SB(b, h) ((4 + (b) * 2 + (h)) * HTB)
#define PG8_STAGE(bufoff, gbase, voff) do { _Pragma("unroll") for (int _i = 0; _i < 2; ++_i) \
        __builtin_amdgcn_global_load_lds((const unsigned*)((const char*)(gbase) + (voff)[_i]), (LAS unsigned*)(lds + (bufoff) + ldsw + _i * 8192), 16, 0, 0); } while (0)
#define PG8_STAGEB(bufoff, gbase, mx) do { \
        __builtin_amdgcn_global_load_lds((const unsigned*)((const char*)(gbase) - ((mx) ? adjB0 : 0) + voffB[0]), (LAS unsigned*)(lds + (bufoff) + ldsw), 16, 0, 0); \
        __builtin_amdgcn_global_load_lds((const unsigned*)((const char*)(gbase) - ((mx) ? adjB1 : 0) + voffB[1]), (LAS unsigned*)(lds + (bufoff) + ldsw + 8192), 16, 0, 0); } while (0)
#define PG8_LDA(dst, b, h) do { _Pragma("unroll") for (int m = 0; m < 4; ++m) _Pragma("unroll") for (int k = 0; k < 2; ++k) dst[m][k] = *(const LAS bf16x8*)(lds + PG8_SA(b, h) + aoff + m * 2048 + k * 1024); } while (0)
#define PG8_LDB(dst, b, h) do { _Pragma("unroll") for (int n = 0; n < 2; ++n) _Pragma("unroll") for (int k = 0; k < 2; ++k) dst[n][k] = *(const LAS bf16x8*)(lds + PG8_SB(b, h) + boff + n * 2048 + k * 1024); } while (0)
#define PG8_MMA(ai, bj, At, Bt) do { __builtin_amdgcn_s_setprio(1); _Pragma("unroll") for (int m = 0; m < 4; ++m) _Pragma("unroll") for (int n = 0; n < 2; ++n) _Pragma("unroll") for (int k = 0; k < 2; ++k) \
        acc[ai][bj][m][n] = __builtin_amdgcn_mfma_f32_16x16x32_bf16(Bt[n][k], At[m][k], acc[ai][bj][m][n], 0, 0, 0); __builtin_amdgcn_s_setprio(0); } while (0)
#define PG8_WAIT_V(n) asm volatile("s_waitcnt vmcnt(" #n ")" ::: "memory")
#define PG8_WAIT_L(n) asm volatile("s_waitcnt lgkmcnt(" #n ")" ::: "memory")
#define PG8_BAR __builtin_amdgcn_s_barrier()
#define PG8_SCHED __builtin_amdgcn_sched_barrier(0)
    Unit cur, nxt; int ui = 0;
    if (!S.next(0, cur)) return;
    const unsigned rsl0 = (unsigned)(uintptr_t)(lds + RSL_OFF);
    if constexpr (Epi::RSL) { if (wid == 0) glds16_(E.rss_panel(cur) + lane * 4, (unsigned)__builtin_amdgcn_readfirstlane((int)rsl0)); }
    const char* cA = (const char*)g.A + (size_t)cur.pm * tstep; const char* cB = (const char*)g.Bt + (size_t)PG8_BROW(cur.pn) * K * 2;
    bool mc = PG8_ISMIX(cur.pn); size_t hbc = mc ? (size_t)(WGB - WU) * K * 2 : hstepB;
    PG8_STAGEB(PG8_SB(0, 0), cB, mc); PG8_STAGEB(PG8_SB(0, 1), cB + hbc, mc); PG8_STAGE(PG8_SA(0, 0), cA, voffA); PG8_STAGE(PG8_SA(0, 1), cA + hstep, voffA);
    if (wr == 1) PG8_BAR;
    PG8_WAIT_V(2); PG8_BAR;
    PG8_STAGEB(PG8_SB(1, 0), cB + kstep, mc); PG8_STAGE(PG8_SA(1, 0), cA + kstep, voffA); PG8_STAGEB(PG8_SB(1, 1), cB + hbc + kstep, mc);
    PG8_WAIT_V(6); PG8_BAR; PG8_SCHED;
    f32x4 acc[2][2][4][2];
#pragma unroll
    for (int a = 0; a < 2; ++a)
#pragma unroll
        for (int b = 0; b < 2; ++b)
#pragma unroll
            for (int m = 0; m < 4; ++m)
#pragma unroll
                for (int n = 0; n < 2; ++n) acc[a][b][m][n] = (f32x4){0.f, 0.f, 0.f, 0.f};
    bf16x8 At[4][2], B0[2][2], B1[2][2];
    for (;;) {
        const bool has_next = S.next(ui + 1, nxt);
        const char* nA = has_next ? (const char*)g.A + (size_t)nxt.pm * tstep : cA; const char* nB = has_next ? (const char*)g.Bt + (size_t)PG8_BROW(nxt.pn) * K * 2 : cB;
        const bool mn = has_next ? PG8_ISMIX(nxt.pn) : mc; const size_t hbn = mn ? (size_t)(WGB - WU) * K * 2 : hstepB;
        for (int t = 0; t < nt; t += 2) {
            const bool last = (t == nt - 2);
            const char* a1 = cA + (size_t)(t + 1) * kstep;
            const char* a2 = last ? nA : cA + (size_t)(t + 2) * kstep; const char* b2 = last ? nB : cB + (size_t)(t + 2) * kstep;
            const char* a3 = a2 + kstep; const char* b3 = b2 + kstep;
            const bool m2 = last ? mn : mc; const size_t hb2 = last ? hbn : hbc;
            PG8_LDB(B0, 0, 0); PG8_LDB(B1, 0, 1); PG8_SCHED; PG8_LDA(At, 0, 0); PG8_STAGE(PG8_SA(1, 1), a1 + hstep, voffA);
            PG8_WAIT_V(8); PG8_WAIT_L(0); PG8_BAR; PG8_MMA(0, 0, At, B0); PG8_MMA(0, 1, At, B1); PG8_BAR; PG8_SCHED;
            PG8_LDA(At, 0, 1); PG8_STAGEB(PG8_SB(0, 0), b2, m2); PG8_STAGEB(PG8_SB(0, 1), b2 + hb2, m2); PG8_STAGE(PG8_SA(0, 0), a2, voffA);
            PG8_WAIT_V(8); PG8_WAIT_L(0); PG8_BAR; PG8_MMA(1, 0, At, B0); PG8_MMA(1, 1, At, B1); PG8_BAR; PG8_SCHED;
            PG8_LDB(B0, 1, 0); PG8_LDB(B1, 1, 1); PG8_SCHED; PG8_LDA(At, 1, 0); PG8_STAGE(PG8_SA(0, 1), a2 + hstep, voffA);
            PG8_WAIT_V(8); PG8_WAIT_L(0); PG8_BAR; PG8_MMA(0, 0, At, B0); PG8_MMA(0, 1, At, B1); PG8_BAR; PG8_SCHED;
            PG8_LDA(At, 1, 1); PG8_STAGEB(PG8_SB(1, 0), b3, m2); PG8_STAGEB(PG8_SB(1, 1), b3 + hb2, m2); PG8_STAGE(PG8_SA(1, 0), a3, voffA);
            PG8_WAIT_V(8); PG8_WAIT_L(0); PG8_BAR; PG8_MMA(1, 0, At, B0); PG8_MMA(1, 1, At, B1); PG8_BAR; PG8_SCHED;
        }
        if (wr == 0) PG8_BAR;
        E(acc, cur, wr, wc, fr, fq, (const LAS float*)(lds + RSL_OFF + (ui & 1) * 1024));
        if (!has_next) break;
#pragma unroll
        for (int a = 0; a < 2; ++a)
#pragma unroll
            for (int b = 0; b < 2; ++b)
#pragma unroll
                for (int m = 0; m < 4; ++m)
#pragma unroll
                    for (int n = 0; n < 2; ++n) acc[a][b][m][n] = (f32x4){0.f, 0.f, 0.f, 0.f};
        cur = nxt; cA = nA; cB = nB; mc = mn; hbc = hbn; ++ui;
        if constexpr (Epi::RSL) { if (wid == 0) glds16_(E.rss_panel(cur) + lane * 4, (unsigned)__builtin_amdgcn_readfirstlane((int)(rsl0 + (ui & 1) * 1024))); }
        if (wr == 1) PG8_BAR;
    }
    PG8_WAIT_V(0);
    PG8_BAR;
#undef PG8_SA
#undef PG8_SB
#undef PG8_STAGE
#undef PG8_LDA
#undef PG8_STAGEB
#undef PG8_BROW
#undef PG8_ISMIX
#undef PG8_LDB
#undef PG8_MMA
#undef PG8_WAIT_V
#undef PG8_WAIT_L
#undef PG8_BAR
#undef PG8_SCHED
}
}

__device__ __forceinline__ unsigned f2bf(float f) { unsigned u = __builtin_bit_cast(unsigned, f); return (u + 0x7fffu + ((u >> 16) & 1u)) >> 16; }
__device__ __forceinline__ unsigned pk2(float lo, float hi) { return f2bf(lo) | (f2bf(hi) << 16); }
__device__ __forceinline__ float bf_lo(unsigned w) { return __uint_as_float(w << 16); }
__device__ __forceinline__ float bf_hi(unsigned w) { return __uint_as_float(w & 0xffff0000u); }
__device__ __forceinline__ float bf2f(bf16_t b) { return __uint_as_float((unsigned)b << 16); }
__device__ __forceinline__ float wave_sum(float v) {
#pragma unroll
    for (int o = 1; o < 64; o <<= 1) v += __shfl_xor(v, o);
    return v;
}

__device__ __forceinline__ int lane_id() { int r; asm volatile("v_mbcnt_lo_u32_b32 %0, -1, 0\n\tv_mbcnt_hi_u32_b32 %0, -1, %0" : "=v"(r)); return r; }

struct Args {
    const float* x; const float* norm_g; const float* w_in; const float* q_norm; const float* k_norm; const float* sinks; const float* w_s; const float* b_s; const float* w_out;
    float* out; unsigned char* ws;
};

__device__ __forceinline__ void p0_transpose_item(const float* W, int K, int N, bf16_t* WT, const float* gk, LAS float* scr, int item, int lane) {
    const int nblk = N / 64, kb = item / nblk, nb = item % nblk, k0 = 64 * kb, n0 = 64 * nb;
    const int r4 = lane >> 4, c4 = lane & 15;
    f32x4 v[16];
#pragma unroll
    for (int i = 0; i < 16; ++i) v[i] = __builtin_nontemporal_load((const f32x4*)(W + (size_t)(k0 + 4 * i + r4) * N + n0 + 4 * c4));
#pragma unroll
    for (int i = 0; i < 16; ++i) { LAS float* d = scr + (4 * i + r4) * 65 + 4 * c4; d[0] = v[i][0]; d[1] = v[i][1]; d[2] = v[i][2]; d[3] = v[i][3]; }
    asm volatile("s_waitcnt lgkmcnt(0)" ::: "memory");
    const int c = lane & 7, ns = lane >> 3;
    float gsc[8];
#pragma unroll
    for (int e = 0; e < 8; ++e) gsc[e] = gk ? gk[k0 + 8 * c + e] : 1.0f;
#pragma unroll
    for (int j = 0; j < 8; ++j) { const int n = 8 * j + ns; const LAS float* sp = scr + (8 * c) * 65 + n;
        u32x4 o; o.x = pk2(sp[0 * 65] * gsc[0], sp[1 * 65] * gsc[1]); o.y = pk2(sp[2 * 65] * gsc[2], sp[3 * 65] * gsc[3]); o.z = pk2(sp[4 * 65] * gsc[4], sp[5 * 65] * gsc[5]); o.w = pk2(sp[6 * 65] * gsc[6], sp[7 * 65] * gsc[7]);
        *(u32x4*)(WT + (size_t)(n0 + n) * K + k0 + 8 * c) = o; }
    asm volatile("s_waitcnt lgkmcnt(0)" ::: "memory");
}
__device__ __forceinline__ void p0_prologue(const Args& a, LAS unsigned char* lds, int wave, int lane) {
    LAS float* scr = (LAS float*)(lds + wave * 18432);
    const int gw = blockIdx.x * NWAVES + wave, NGW = gridDim.x * NWAVES;
    constexpr int I_IN = (DM / 64) * (DIN / 64), I_OUT = (DM / 64) * (DM / 64), I_L = I_IN + I_OUT;
    for (int it = gw; it < DEPTH * I_L; it += NGW) {
        const int l = it / I_L; int r = it % I_L;
        if (r < I_IN) p0_transpose_item(a.w_in + (size_t)l * DM * DIN, DM, DIN, (bf16_t*)(a.ws + WS_WIN + l * WIN_L), a.norm_g + l * DM, scr, r, lane);
        else p0_transpose_item(a.w_out + (size_t)l * DM * DM, DM, DM, (bf16_t*)(a.ws + WS_WOUT + l * WOUT_L), nullptr, scr, r - I_IN, lane);
    }
    { const int gt = blockIdx.x * (NWAVES * 64) + threadIdx.x, NT = gridDim.x * NWAVES * 64; bf16_t* wsb = (bf16_t*)(a.ws + WS_WSB);
      for (int i = gt; i < DEPTH * 16 * 128 * 128; i += NT) { const int s = i & 127, t = (i >> 7) & 127; wsb[i] = (s <= t) ? (bf16_t)f2bf(a.w_s[i]) : (bf16_t)0; }
      float* rss = (float*)(a.ws + WS_RSS);
      for (int i = gt; i < (DEPTH - 1) * M; i += NT) rss[M + i] = 0.f; }
    { float* rss = (float*)(a.ws + WS_RSS); bf16_t* xb = (bf16_t*)(a.ws + WS_XB);
      for (int m = gw; m < M; m += NGW) {
          const f32x4* xr = (const f32x4*)(a.x + (size_t)m * DM) + lane; u32x2* o = (u32x2*)(xb + (size_t)m * DM) + lane; float s = 0.f;
#pragma unroll
          for (int j = 0; j < 8; ++j) { const f32x4 v = __builtin_nontemporal_load(xr + 64 * j); s += (v[0] * v[0] + v[1] * v[1]) + (v[2] * v[2] + v[3] * v[3]); u32x2 w; w.x = pk2(v[0], v[1]); w.y = pk2(v[2], v[3]); o[64 * j] = w; }
          s = wave_sum(s); if (lane == 0) rss[m] = s; } }
}

typedef short v4i16_t __attribute__((ext_vector_type(4)));
__device__ __forceinline__ bf16x8 tr_frag(LAS unsigned char* pa, LAS unsigned char* pb) {
    const v4i16_t lo = __builtin_amdgcn_ds_read_tr16_b64_v4i16((LAS v4i16_t*)pa), hi = __builtin_amdgcn_ds_read_tr16_b64_v4i16((LAS v4i16_t*)pb);
    return __builtin_shufflevector(lo, hi, 0, 1, 2, 3, 4, 5, 6, 7);
}
__device__ __forceinline__ int img_swz(int row) { return (((row >> 1) & 3) << 1) | ((row >> 3) & 1); }
__device__ __forceinline__ int vimg_off(int row, int c8) { return row * 128 + (((c8 >> 1) ^ img_swz(row)) << 4) + ((c8 & 1) << 3); }
#define MFMA16(x, y, c) __builtin_amdgcn_mfma_f32_16x16x32_bf16((x), (y), (c), 0, 0, 0)

#define SBAR0() __builtin_amdgcn_sched_barrier(0)
__device__ __forceinline__ void glds16(const void* gsrc, unsigned lds_dst) { unsigned keep;
    asm volatile("s_mov_b32 %0, m0\n\ts_mov_b32 m0, %2\n\ts_nop 0\n\tglobal_load_lds_dwordx4 %1, off\n\ts_mov_b32 m0, %0" : "=&s"(keep) : "v"(gsrc), "s"(lds_dst) : "memory"); }
__device__ __forceinline__ void attn_mfma(const bf16_t* proj, bf16_t* mix, const float* sinks, LAS unsigned char* lds, int wave, int lane_) {
    int lane = lane_; asm volatile("" : "+v"(lane));
    const int fr = lane & 15, fq = lane >> 4, q4 = (lane & 15) >> 2, p4 = lane & 3;
    for (int blk = blockIdx.x; blk < M / 128; blk += gridDim.x) {
        const int t0 = blk * 128; const bool first = (blk & (SEQ / 128 - 1)) == 0;
        const int tq = t0 + 16 * wave + fr;
        const bf16_t* qrow = proj + (size_t)tq * DP;
        const float sinkv = sinks[lane & 15] * LOG2E;
        const unsigned lds0 = (unsigned)(uintptr_t)lds;
#define DMA_KV(HK, BUF) do { _Pragma("unroll") for (int i4 = 0; i4 < 4; ++i4) { const int ii = 4 * wave + i4, rr = 8 * ii + (lane >> 3), k = (lane & 7) ^ img_swz(rr); \
            int tok = t0 - 128 + rr; if (first && tok < t0) tok = t0; const bf16_t* src = proj + (size_t)tok * DP + 64 * (HK) + 8 * k; \
            glds16(src + CK, (unsigned)__builtin_amdgcn_readfirstlane((int)(lds0 + (BUF) * 65536 + ii * 1024))); \
            glds16(src + CV, (unsigned)__builtin_amdgcn_readfirstlane((int)(lds0 + (BUF) * 65536 + 32768 + ii * 1024))); } } while (0)
#define LOADQ(DST, HQ0) do { _Pragma("unroll") for (int g2 = 0; g2 < 2; ++g2) _Pragma("unroll") for (int s = 0; s < 2; ++s) DST[g2][s] = *(const bf16x8*)(qrow + CQ + 64 * ((HQ0) + g2) + 32 * s + 8 * fq); } while (0)
        asm volatile("s_waitcnt lgkmcnt(0)\n\ts_barrier" ::: "memory");
        DMA_KV(0, 0);
        bf16x8 qn[2][2];
        LOADQ(qn, 0);
        const int kro = 16 * wave + fr;
        const int kof0 = vimg_off(kro, 2 * fq), kof1 = vimg_off(kro, 2 * (4 + fq));
#pragma unroll 1
        for (int hk = 0; hk < 4; ++hk) {
            asm volatile("s_waitcnt vmcnt(0) lgkmcnt(0)\n\ts_barrier" ::: "memory");
            LAS unsigned char* kb = lds + (hk & 1) * 65536; LAS unsigned char* vb = kb + 32768;
#pragma unroll
            for (int gp = 0; gp < 2; ++gp) {
                const int hq0 = 4 * hk + 2 * gp;
                bf16x8 qf[2][2];
#pragma unroll
                for (int g2 = 0; g2 < 2; ++g2)
#pragma unroll
                    for (int s = 0; s < 2; ++s) qf[g2][s] = qn[g2][s];
                if (hq0 + 2 < 16) LOADQ(qn, hq0 + 2);
                u32x4 gav[2][2];
#pragma unroll
                for (int g2 = 0; g2 < 2; ++g2)
#pragma unroll
                    for (int a2 = 0; a2 < 2; ++a2) gav[g2][a2] = *(const u32x4*)(qrow + CGA + 64 * (hq0 + g2) + 32 * a2 + 8 * fq);
                float sref[2], sterm[2]; f32x4 cb[2]; float stp[2];
#pragma unroll
                for (int g2 = 0; g2 < 2; ++g2) {
                    const int hq = hq0 + g2; const float slope2 = exp2f(-0.5f * (float)(hq + 1)) * LOG2E, sink2 = __uint_as_float(__builtin_amdgcn_readlane(__float_as_uint(sinkv), hq));
                    sref[g2] = fminf(fmaxf(sink2, -60.f), 60.f); sterm[g2] = __builtin_amdgcn_exp2f(sink2 - sref[g2]); stp[g2] = slope2 * 16.0f;
                    const float b0 = slope2 * (float)(4 * fq - 128 - fr) - sref[g2];
                    cb[g2] = (f32x4){b0, b0 + slope2, b0 + 2.0f * slope2, b0 + 3.0f * slope2};
                }
                f32x4 S[2][9];
#pragma unroll
                for (int j = 0; j < 9; ++j) {
                    const bf16x8 k0 = *(const LAS bf16x8*)(kb + kof0 + j * 2048), k1 = *(const LAS bf16x8*)(kb + kof1 + j * 2048);
#pragma unroll
                    for (int g2 = 0; g2 < 2; ++g2) {
                        f32x4 c = cb[g2] + stp[g2] * (float)j;
                        if (j == 0) {
#pragma unroll
                            for (int i = 0; i < 4; ++i) c[i] = (4 * fq + i > fr) ? c[i] : -INFINITY; }
                        if (j == 8) {
#pragma unroll
                            for (int i = 0; i < 4; ++i) c[i] = (4 * fq + i <= fr) ? c[i] : -INFINITY; }
                        if (first && j < 8 - wave) c = (f32x4){-INFINITY, -INFINITY, -INFINITY, -INFINITY};
                        S[g2][j] = MFMA16(k0, qf[g2][0], c); S[g2][j] = MFMA16(k1, qf[g2][1], S[g2][j]); }
                }
                SBAR0();
                if (gp == 0 && hk < 3) { if (hk & 1) DMA_KV(hk + 1, 0); else DMA_KV(hk + 1, 1); }
                SBAR0();
                bf16x8 pf[2][5]; float il[2];
                const bf16x8 ones = {0x3F80, 0x3F80, 0x3F80, 0x3F80, 0x3F80, 0x3F80, 0x3F80, 0x3F80};
#pragma unroll
                for (int g2 = 0; g2 < 2; ++g2) {
                    f32x4 L = (f32x4){0.f, 0.f, 0.f, 0.f};
#pragma unroll
                    for (int c = 0; c < 5; ++c) { u32x4 w;
                        w.x = pg8::cvt_pk_bf16(__builtin_amdgcn_exp2f(S[g2][2 * c][0]), __builtin_amdgcn_exp2f(S[g2][2 * c][1])); w.y = pg8::cvt_pk_bf16(__builtin_amdgcn_exp2f(S[g2][2 * c][2]), __builtin_amdgcn_exp2f(S[g2][2 * c][3]));
                        if (c < 4) { w.z = pg8::cvt_pk_bf16(__builtin_amdgcn_exp2f(S[g2][2 * c + 1][0]), __builtin_amdgcn_exp2f(S[g2][2 * c + 1][1])); w.w = pg8::cvt_pk_bf16(__builtin_amdgcn_exp2f(S[g2][2 * c + 1][2]), __builtin_amdgcn_exp2f(S[g2][2 * c + 1][3])); } else { w.z = 0u; w.w = 0u; }
                        pf[g2][c] = __builtin_bit_cast(bf16x8, w);
                        L = MFMA16(ones, pf[g2][c], L); }
                    il[g2] = __builtin_amdgcn_rcpf(L[0] + sterm[g2]);
                }
                SBAR0();
                f32x4 O[2][4];
#pragma unroll
                for (int g2 = 0; g2 < 2; ++g2)
#pragma unroll
                    for (int dt = 0; dt < 4; ++dt) O[g2][dt] = (f32x4){0.f, 0.f, 0.f, 0.f};
#pragma unroll
                for (int c = 0; c < 5; ++c) {
                    bf16x8 vf[4];
#pragma unroll
                    for (int dt = 0; dt < 4; ++dt) { const int ra = 16 * wave + 32 * c + 4 * fq + q4, rb = (c < 4) ? ra + 16 : ra, c8 = 8 * (dt >> 1) + 2 * p4 + (dt & 1);
                        vf[dt] = tr_frag(vb + vimg_off(ra, c8), vb + vimg_off(rb, c8)); }
#pragma unroll
                    for (int dt = 0; dt < 4; ++dt)
#pragma unroll
                        for (int g2 = 0; g2 < 2; ++g2) O[g2][dt] = MFMA16(vf[dt], pf[g2][c], O[g2][dt]);
                }
#pragma unroll
                for (int g2 = 0; g2 < 2; ++g2)
#pragma unroll
                    for (int a2 = 0; a2 < 2; ++a2) {
                        const int col = 64 * (hq0 + g2) + 32 * a2 + 8 * fq; const u32x4 ga = gav[g2][a2];
                        const f32x4 o0 = O[g2][2 * a2] * il[g2], o1 = O[g2][2 * a2 + 1] * il[g2];
                        u32x4 r; r.x = pg8::cvt_pk_bf16(o0[0] * bf_lo(ga.x), o0[1] * bf_hi(ga.x)); r.y = pg8::cvt_pk_bf16(o0[2] * bf_lo(ga.y), o0[3] * bf_hi(ga.y));
                        r.z = pg8::cvt_pk_bf16(o1[0] * bf_lo(ga.z), o1[1] * bf_hi(ga.z)); r.w = pg8::cvt_pk_bf16(o1[2] * bf_lo(ga.w), o1[3] * bf_hi(ga.w));
                        *(u32x4*)(mix + (size_t)tq * DM + col) = r;
                    }
            }
        }
        asm volatile("s_waitcnt lgkmcnt(0)\n\ts_barrier" ::: "memory");
#undef DMA_KV
#undef LOADQ
    }
}
__device__ __forceinline__ void sgu_mfma(const bf16_t* proj, bf16_t* mix, const bf16_t* wsb, const float* bs, LAS unsigned char* vl, int wave, int lane_) {
    int lane = lane_; asm volatile("" : "+v"(lane));
    const int fr = lane & 15, fq = lane >> 4, q4 = (lane & 15) >> 2, p4 = lane & 3;
    for (int blk = blockIdx.x; blk < M / 128; blk += gridDim.x) {
        const int t0 = blk * 128;
#pragma unroll 1
        for (int hh = 0; hh < 2; ++hh) {
            const int h = wave + 8 * hh;
            asm volatile("s_waitcnt lgkmcnt(0)" ::: "memory");
#pragma unroll
            for (int ii = 0; ii < 16; ++ii) {
                const int rr = 8 * ii + (lane >> 3), k = (lane & 7) ^ img_swz(rr);
                __builtin_amdgcn_global_load_lds((const unsigned*)(proj + (size_t)(t0 + rr) * DP + CVS + 64 * h + 8 * k), (LAS unsigned*)(vl + ii * 1024), 16, 0, 0);
            }
            bf16x8 wf[2][2][4]; float bias[2][2];
#define LOADG(BUF, G) do { _Pragma("unroll") for (int ti = 0; ti < 2; ++ti) { const int t = 16 * (2 * (G) + ti) + fr; bias[BUF][ti] = bs[h * 128 + t]; \
                _Pragma("unroll") for (int kc = 0; kc <= (G); ++kc) wf[BUF][ti][kc] = *(const bf16x8*)(wsb + ((size_t)h * 128 + t) * 128 + 32 * kc + 8 * fq); } } while (0)
            LOADG(0, 0);
            asm volatile("s_waitcnt vmcnt(0)" ::: "memory");
#pragma unroll
            for (int g = 0; g < 4; ++g) {
                if (g < 3) LOADG((g + 1) & 1, g + 1);
                u32x4 ub[2][2];
#pragma unroll
                for (int ti = 0; ti < 2; ++ti)
#pragma unroll
                    for (int a2 = 0; a2 < 2; ++a2) ub[ti][a2] = *(const u32x4*)(proj + (size_t)(t0 + 16 * (2 * g + ti) + fr) * DP + CUG + 64 * h + 32 * a2 + 8 * fq);
                SBAR0();
                f32x4 acc[2][4];
#pragma unroll
                for (int ti = 0; ti < 2; ++ti)
#pragma unroll
                    for (int ct = 0; ct < 4; ++ct) { const float b = bias[g & 1][ti]; acc[ti][ct] = (f32x4){b, b, b, b}; }
#pragma unroll
                for (int kc = 0; kc <= g; ++kc) {
                    bf16x8 vf[4];
#pragma unroll
                    for (int ct = 0; ct < 4; ++ct) { const int ra = 32 * kc + 8 * fq + q4, c8 = 8 * (ct >> 1) + 2 * p4 + (ct & 1); vf[ct] = tr_frag(vl + vimg_off(ra, c8), vl + vimg_off(ra + 4, c8)); }
#pragma unroll
                    for (int ct = 0; ct < 4; ++ct)
#pragma unroll
                        for (int ti = 0; ti < 2; ++ti) acc[ti][ct] = MFMA16(vf[ct], wf[g & 1][ti][kc], acc[ti][ct]);
                }
#pragma unroll
                for (int ti = 0; ti < 2; ++ti)
#pragma unroll
                    for (int a2 = 0; a2 < 2; ++a2) {
                        const int t = 16 * (2 * g + ti) + fr; const u32x4 u = ub[ti][a2]; const f32x4 o0 = acc[ti][2 * a2], o1 = acc[ti][2 * a2 + 1];
                        u32x4 r; r.x = pg8::cvt_pk_bf16(o0[0] * bf_lo(u.x), o0[1] * bf_hi(u.x)); r.y = pg8::cvt_pk_bf16(o0[2] * bf_lo(u.y), o0[3] * bf_hi(u.y));
                        r.z = pg8::cvt_pk_bf16(o1[0] * bf_lo(u.z), o1[1] * bf_hi(u.z)); r.w = pg8::cvt_pk_bf16(o1[2] * bf_lo(u.w), o1[3] * bf_hi(u.w));
                        *(u32x4*)(mix + (size_t)(t0 + t) * DM + 1024 + 64 * h + 32 * a2 + 8 * fq) = r;
                    }
            }
#undef LOADG
        }
    }
}

#define XB_TMO      128
#define XB_XCNT(j)  (256  + 64 * (j))
#define XB_XSUB(j)  (1280 + 64 * (j))
#define XB_XGEN(j)  (2304 + 64 * (j))
#define XB_TOP      3328
#define XB_TOPGEN   3392
#define XCD_BAR_WORDS 3456
#define XB_SPIN_CAP (1u << 20)
__device__ __forceinline__ unsigned xb_ld(unsigned* p)              { return __hip_atomic_load(p, __ATOMIC_RELAXED, __HIP_MEMORY_SCOPE_AGENT); }
__device__ __forceinline__ unsigned xb_add(unsigned* p, unsigned v) { return __hip_atomic_fetch_add(p, v, __ATOMIC_RELAXED, __HIP_MEMORY_SCOPE_AGENT); }
__device__ __forceinline__ unsigned xb_xcc_id() { return (unsigned)__builtin_amdgcn_s_getreg((3 << 11) | 20) & 0xFu; }
#define XB_SPIN(cond, bar) do { unsigned _sp = 0; while (cond) { __builtin_amdgcn_s_sleep(1); \
    if ((++_sp & 255u) == 0u) { if (xb_ld(&(bar)[XB_TMO])) break; if (_sp > XB_SPIN_CAP) { atomicAdd(&(bar)[XB_TMO], 1u); break; } } } } while (0)
struct XcdBarrier { unsigned* bar; unsigned x; volatile LAS unsigned* st; };
__device__ __forceinline__ XcdBarrier xcd_barrier_post(unsigned* bar, volatile LAS unsigned* st) {
    XcdBarrier b; b.bar = bar; b.x = xb_xcc_id(); b.st = st;
    if (threadIdx.x == 0) (void)xb_add(&bar[XB_XCNT(b.x)], 1u);
    return b;
}
__device__ __forceinline__ void xcd_barrier_complete(unsigned* bar, unsigned x, unsigned& nloc, unsigned& nx) {
    const unsigned G = gridDim.x * gridDim.y * gridDim.z;
    unsigned sum, cnt, mine, sp = 0u;
    for (;;) {
        sum = 0u; cnt = 0u; mine = 0u;
#pragma unroll
        for (unsigned j = 0; j < 16; ++j) { const unsigned c = xb_ld(&bar[XB_XCNT(j)]); sum += c; cnt += (c > 0u) ? 1u : 0u; mine = (j == x) ? c : mine; }
        if (sum == G) break;
        __builtin_amdgcn_s_sleep(1);
        if ((++sp & 255u) == 0u) { if (xb_ld(&bar[XB_TMO])) break; if (sp > XB_SPIN_CAP) { atomicAdd(&bar[XB_TMO], 1u); break; } }
    }
    nloc = mine > 0u ? mine : 1u; nx = cnt > 0u ? cnt : 1u;
}
__device__ __forceinline__ void xcd_barrier(const XcdBarrier& b, bool thread0) {
    asm volatile("s_waitcnt vmcnt(0)" ::: "memory");
    __syncthreads();
    if (thread0) {
        unsigned* bar = b.bar;
        __builtin_amdgcn_s_waitcnt(0);
        unsigned nloc = b.st[0], nx = b.st[1];
        if (nloc == 0u) { xcd_barrier_complete(bar, b.x, nloc, nx); b.st[0] = nloc; b.st[1] = nx; }
        const unsigned old = xb_add(&bar[XB_XSUB(b.x)], 1u);
        const unsigned gen = old / nloc;
        if (old + 1u == (gen + 1u) * nloc) {
            __builtin_amdgcn_fence(__ATOMIC_RELEASE, "agent");
            asm volatile("s_waitcnt vmcnt(0)" ::: "memory");
            const unsigned og = xb_add(&bar[XB_TOP], 1u);
            const unsigned tg = og / nx;
            if (og + 1u == (tg + 1u) * nx) xb_add(&bar[XB_TOPGEN], 1u);
            else XB_SPIN(xb_ld(&bar[XB_TOPGEN]) == tg, bar);
            __builtin_amdgcn_fence(__ATOMIC_ACQUIRE, "agent");
            xb_add(&bar[XB_XGEN(b.x)], 1u);
            asm volatile("s_waitcnt vmcnt(0)" ::: "memory");
        } else {
            XB_SPIN(xb_ld(&bar[XB_XGEN(b.x)]) == gen, bar);
            __builtin_amdgcn_fence(__ATOMIC_ACQUIRE, "agent");
            asm volatile("s_waitcnt vmcnt(0)" ::: "memory");
        }
    }
    __syncthreads();
}

__global__ void __launch_bounds__(NWAVES * 64, 2) hybrid_fwd(Args a) {
    extern __shared__ __attribute__((aligned(16))) unsigned char lds_raw[];
    LAS unsigned char* lds = (LAS unsigned char*)lds_raw;
    cg::grid_group grid = cg::this_grid();
    const int tid = threadIdx.x, lane = tid & 63, wave = __builtin_amdgcn_readfirstlane(tid >> 6);
    unsigned char* ws = a.ws;
    bf16_t* xb = (bf16_t*)(ws + WS_XB); bf16_t* proj = (bf16_t*)(ws + WS_PROJ); bf16_t* mix = (bf16_t*)(ws + WS_MIX); float* rss = (float*)(ws + WS_RSS);

    volatile LAS unsigned* misc = (volatile LAS unsigned*)(lds + MISC_OFF);
    if (tid < 64) misc[tid] = 0u;
    if (blockIdx.x == 0) { unsigned* bw = (unsigned*)(ws + WS_BAR); for (int i = tid; i < XCD_BAR_WORDS; i += NWAVES * 64) bw[i] = 0u; }
    p0_prologue(a, lds, wave, lane);
    grid.sync();
    const XcdBarrier bar = xcd_barrier_post((unsigned*)(ws + WS_BAR), misc);
#define GRID_BAR() xcd_barrier(bar, wave == 0 && lane_id() == 0)
    for (int l = 0; l < DEPTH; ++l) {
        {
            pg8::Gemm g{xb, (const bf16_t*)(ws + WS_WIN + l * WIN_L), M, DIN, DM}; pg8::StaticOrder S; S.init(M, DIN, (int)gridDim.x, (int)blockIdx.x);
            pg8::EpiProj E{proj, rss + (size_t)l * M, a.q_norm + l * HD, a.k_norm + l * HD};
            for (int rep = 0; rep < REP_G1; ++rep) pg8::gemm_phase<pg8::EpiProj, pg8::StaticOrder>(lds, g, S, E, wave * 64 + lane_id());
        }
        GRID_BAR();
        for (int rep = 0; rep < REP_MIX; ++rep) {
        attn_mfma(proj, mix, a.sinks + l * 16, lds, wave, lane_id());
        sgu_mfma(proj, mix, (const bf16_t*)(ws + WS_WSB + l * WSB_L), a.b_s + l * 16 * 128, lds + wave * 18432, wave, lane_id());
        asm volatile("s_waitcnt vmcnt(0) lgkmcnt(0)" ::: "memory");
        }
        GRID_BAR();
        {
            pg8::Gemm g{mix, (const bf16_t*)(ws + WS_WOUT + l * WOUT_L), M, DM, DM}; pg8::StaticOrder S; S.init(M, DM, (int)gridDim.x, (int)blockIdx.x);
            float* rn = rss + (size_t)(l + 1 < DEPTH ? l + 1 : 0) * M;
            if (l == 0) { pg8::EpiRes<true, false> E{a.x, nullptr, xb, rn}; pg8::gemm_phase<pg8::EpiRes<true, false>, pg8::StaticOrder>(lds, g, S, E, wave * 64 + lane_id()); }
            else if (l + 1 < DEPTH) { pg8::EpiRes<false, false> E{nullptr, nullptr, xb, rn}; pg8::gemm_phase<pg8::EpiRes<false, false>, pg8::StaticOrder>(lds, g, S, E, wave * 64 + lane_id()); }
            else { pg8::EpiRes<false, true> E{nullptr, a.out, xb, nullptr}; pg8::gemm_phase<pg8::EpiRes<false, true>, pg8::StaticOrder>(lds, g, S, E, wave * 64 + lane_id()); }
        }
        if (l + 1 < DEPTH) GRID_BAR();
    }
}

extern "C" void kernel_launch(void* const* d_in, const int* in_sizes, int n_in, void* d_out, int out_size, void* d_ws, size_t ws_size, hipStream_t stream) {
    static int grid = 0;
    if (grid == 0) {
        if (n_in != 9 || in_sizes[0] != M * DM || out_size != M * DM || ws_size < WS_END) { fprintf(stderr, "kernel_launch: unexpected shapes / workspace (n_in %d, in0 %d, out %d, ws %zu < %zu)\n", n_in, n_in > 0 ? in_sizes[0] : -1, out_size, ws_size, (size_t)WS_END); grid = -1; return; }
        int dev = 0, cus = 0, per_cu = 0;
        hipGetDevice(&dev); hipDeviceGetAttribute(&cus, hipDeviceAttributeMultiprocessorCount, dev);
        if (hipFuncSetAttribute((const void*)hybrid_fwd, hipFuncAttributeMaxDynamicSharedMemorySize, LDS_BYTES) != hipSuccess) { fprintf(stderr, "kernel_launch: hipFuncSetAttribute failed\n"); grid = -1; return; }
        if (hipOccupancyMaxActiveBlocksPerMultiprocessor(&per_cu, (const void*)hybrid_fwd, NWAVES * 64, LDS_BYTES) != hipSuccess || per_cu < 1) { fprintf(stderr, "kernel_launch: occupancy query says %d\n", per_cu); per_cu = 1; }
        (void)hipGetLastError();
        grid = cus;
    }
    if (grid < 0) return;
    Args a{};
    a.x = (const float*)d_in[0]; a.norm_g = (const float*)d_in[1]; a.w_in = (const float*)d_in[2]; a.q_norm = (const float*)d_in[3]; a.k_norm = (const float*)d_in[4];
    a.sinks = (const float*)d_in[5]; a.w_s = (const float*)d_in[6]; a.b_s = (const float*)d_in[7]; a.w_out = (const float*)d_in[8];
    a.out = (float*)d_out; a.ws = (unsigned char*)d_ws;
    void* args[] = {&a};
    hipError_t e = hipLaunchCooperativeKernel((const void*)hybrid_fwd, dim3(grid), dim3(NWAVES * 64), args, LDS_BYTES, stream);
    if (e != hipSuccess) fprintf(stderr, "kernel_launch: cooperative launch failed: %s (grid %d)\n", hipGetErrorString(e), grid);
}
```
